# Optimizing an MI355X kernel written in HIP

```python
import math
import jax, jax.numpy as jnp
from jax import lax
import numpy as np

D_MODEL = 1024
BATCH = 4
SEQ = 4096
DEPTH = 4

CHUNK = 64
N_A_LAYERS = DEPTH // 2
N_B_LAYERS = DEPTH - N_A_LAYERS
EXPAND = 2
D_INNER = EXPAND * D_MODEL
GMLP_BLOCK = 128
GMLP_GROUPS = 8
GMLP_GROUP_DIM = D_INNER // GMLP_GROUPS
SB_HEADS = 16
SB_HEAD_DIM = D_INNER // SB_HEADS
Q_BLOCK = 128
EPS = 1e-6

kernel_name = 'yoco_gmlp_stickbreaking_encoder'


def rmsnorm(x, g):
    xf = x.astype(jnp.float32)
    y = xf * lax.rsqrt(jnp.mean(xf * xf, axis=-1, keepdims=True) + EPS)
    return (y * g.astype(jnp.float32)).astype(x.dtype)


def layernorm(x, g, b):
    xf = x.astype(jnp.float32)
    mu = jnp.mean(xf, axis=-1, keepdims=True)
    xc = xf - mu
    var = jnp.mean(xc * xc, axis=-1, keepdims=True)
    y = xc * lax.rsqrt(var + EPS) * g.astype(jnp.float32) + b.astype(jnp.float32)
    return y.astype(x.dtype)


def chunk_causal_mask(n):
    c = jnp.arange(n) // CHUNK
    return c[:, None] >= c[None, :]


def gmlp_mixer(h, w_in, ln_g, ln_b, w_s, b_s, w_out):
    B, S, _ = h.shape
    u, v, z = jnp.split(h @ w_in, 3, axis=-1)
    u = jax.nn.gelu(u)
    v = layernorm(jax.nn.gelu(v), ln_g, ln_b)
    nb = S // GMLP_BLOCK
    v = v.reshape(B, nb, GMLP_BLOCK, GMLP_GROUPS, GMLP_GROUP_DIM)
    w = w_s * chunk_causal_mask(GMLP_BLOCK)[None].astype(w_s.dtype)
    s = jnp.einsum('gts,bnsgc->bntgc', w, v) + b_s.T[None, None, :, :, None]
    s = s.reshape(B, S, D_INNER)
    y = u * s * jax.nn.silu(z)
    return y @ w_out


def stick_breaking_mixer(h, k, v, w_in, w_out):
    B, S, _ = h.shape
    q, z = jnp.split(h @ w_in, 2, axis=-1)
    q = q.reshape(B, S, SB_HEADS, SB_HEAD_DIM).transpose(0, 2, 1, 3)
    scale = 1.0 / math.sqrt(SB_HEAD_DIM)
    outs = []
    for start in range(0, S, Q_BLOCK):
        end = start + Q_BLOCK
        qb = q[:, :, start:end].astype(jnp.float32)
        kb = k[:, :, :end].astype(jnp.float32)
        vb = v[:, :, :end].astype(jnp.float32)
        logits = jnp.einsum('bhtd,bhsd->bhts', qb, kb) * scale
        strict = jnp.arange(end)[None, :] < jnp.arange(start, end)[:, None]
        log_beta = jax.nn.log_sigmoid(logits)
        log_1m = jnp.where(strict, jax.nn.log_sigmoid(-logits), 0.0)
        after = lax.cumsum(log_1m, axis=3, reverse=True) - log_1m
        att = jnp.where(strict, jnp.exp(log_beta + after), 0.0)
        outs.append(jnp.einsum('bhts,bhsd->bhtd', att, vb))
    o = jnp.concatenate(outs, axis=2).astype(h.dtype)
    o = o.transpose(0, 2, 1, 3).reshape(B, S, D_INNER)
    y = o * jax.nn.silu(z)
    return y @ w_out


def setup_inputs(seed: int = 0) -> dict:
    key = jax.random.key(seed)
    ks = jax.random.split(key, 16)

    def dense(k, shape, fan_in, mult=1.0):
        return jax.random.normal(k, shape, jnp.float32) * (mult * fan_in ** -0.5)

    def gain(k, shape):
        return 1.0 + 0.05 * jax.random.normal(k, shape, jnp.float32)

    x = jax.random.normal(ks[0], (BATCH, SEQ, D_MODEL), jnp.float32)
    a_norm = gain(ks[1], (N_A_LAYERS, D_MODEL))
    a_w_in = dense(ks[2], (N_A_LAYERS, D_MODEL, 3 * D_INNER), D_MODEL)
    a_ln_g = gain(ks[3], (N_A_LAYERS, D_INNER))
    a_ln_b = 0.02 * jax.random.normal(ks[4], (N_A_LAYERS, D_INNER), jnp.float32)
    a_w_s = dense(ks[5], (N_A_LAYERS, GMLP_GROUPS, GMLP_BLOCK, GMLP_BLOCK), GMLP_BLOCK, 0.5)
    a_b_s = 1.0 + 0.1 * jax.random.normal(ks[6], (N_A_LAYERS, GMLP_GROUPS, GMLP_BLOCK), jnp.float32)
    a_w_out = dense(ks[7], (N_A_LAYERS, D_INNER, D_MODEL), D_INNER)
    kv_norm = gain(ks[8], (D_MODEL,))
    w_kv = dense(ks[9], (D_MODEL, 2 * D_INNER), D_MODEL)
    b_norm = gain(ks[10], (N_B_LAYERS, D_MODEL))
    b_w_in = dense(ks[11], (N_B_LAYERS, D_MODEL, 2 * D_INNER), D_MODEL)
    b_w_out = dense(ks[12], (N_B_LAYERS, D_INNER, D_MODEL), D_INNER)
    final_norm = gain(ks[13], (D_MODEL,))
    return {'x': x, 'a_norm': a_norm, 'a_w_in': a_w_in, 'a_ln_g': a_ln_g, 'a_ln_b': a_ln_b,
            'a_w_s': a_w_s, 'a_b_s': a_b_s, 'a_w_out': a_w_out, 'kv_norm': kv_norm, 'w_kv': w_kv,
            'b_norm': b_norm, 'b_w_in': b_w_in, 'b_w_out': b_w_out, 'final_norm': final_norm}


def reference(x, a_norm, a_w_in, a_ln_g, a_ln_b, a_w_s, a_b_s, a_w_out, kv_norm, w_kv,
              b_norm, b_w_in, b_w_out, final_norm):
    B, S, _ = x.shape
    k = v = None
    for layer in range(DEPTH):
        if layer < N_A_LAYERS:
            i = layer
            h = rmsnorm(x, a_norm[i])
            x = x + gmlp_mixer(h, a_w_in[i], a_ln_g[i], a_ln_b[i], a_w_s[i], a_b_s[i], a_w_out[i])
        else:
            if k is None:
                hk = rmsnorm(x, kv_norm)
                k, v = jnp.split(hk @ w_kv, 2, axis=-1)
                k = k.reshape(B, S, SB_HEADS, SB_HEAD_DIM).transpose(0, 2, 1, 3)
                v = v.reshape(B, S, SB_HEADS, SB_HEAD_DIM).transpose(0, 2, 1, 3)
            i = layer - N_A_LAYERS
            h = rmsnorm(x, b_norm[i])
            x = x + stick_breaking_mixer(h, k, v, b_w_in[i], b_w_out[i])
    return rmsnorm(x, final_norm)
```

```cpp
#include <hip/hip_runtime.h>
#include <hip/hip_cooperative_groups.h>
#include <cstdio>
#include <cstdint>
namespace cg = cooperative_groups;
#define REP_SYNC 0
#define REP_P0 0
#define REP_A1 0
#define REP_A2 0
#define REP_B2 0
#define REP_B1 0
#define REP_A3 0
#define GSYNC(xb) do { xcd_barrier(xb); for (int r_ = 0; r_ < REP_SYNC; ++r_) xcd_barrier(xb); } while (0)

#define LAS __attribute__((address_space(3)))
typedef unsigned short bf16_t;
typedef short bf16x8 __attribute__((ext_vector_type(8)));
typedef float f32x4 __attribute__((ext_vector_type(4)));
typedef float f32x16 __attribute__((ext_vector_type(16)));
typedef float f32x2 __attribute__((ext_vector_type(2)));
typedef unsigned u32x4 __attribute__((ext_vector_type(4)));
typedef unsigned u32x2 __attribute__((ext_vector_type(2)));

constexpr int DM = 1024, NB = 4, SEQ = 4096, MT = NB * SEQ  , DI = 2048, NH = 16, DH = 128;
constexpr float EPS = 1e-6f;
constexpr float LOG2E = 1.4426950408889634f;
constexpr float QSCALE = 0.08838834764831845f * LOG2E;
constexpr float GELU_K = 2.0f * 0.7978845608028654f * LOG2E;

constexpr size_t MiB = 1024ull * 1024ull;
constexpr size_t WS_R0 = 0, WS_R1 = 64 * MiB, WS_R2 = 128 * MiB, WS_XB = 192 * MiB, WS_WB = 224 * MiB;
constexpr size_t Mi = 1024ull * 1024ull;
constexpr size_t WA_LAYER = 8 * Mi, WA_UZ = 0, WA_V = 4 * Mi, WA_OUT = 6 * Mi;
constexpr size_t WB_K = 0, WB_Q0 = 2 * Mi, WB_Z0 = 4 * Mi, WB_VV = 6 * Mi, WB_Q1 = 8 * Mi, WB_Z1 = 10 * Mi, WB_OUT0 = 12 * Mi, WB_OUT1 = 14 * Mi;

__device__ float g_part[MT * 4];
__device__ float g_lnpart[MT * 32];
__device__ bf16_t g_wsm[2 * 8 * 128 * 128];
__device__ unsigned g_cnt[64 * 16];

__device__ __forceinline__ unsigned pk2(float lo, float hi) { unsigned r; asm volatile("v_cvt_pk_bf16_f32 %0, %1, %2" : "=v"(r) : "v"(lo), "v"(hi)); return r; }
__device__ __forceinline__ void store16_wt(void* p, u32x4 v) { asm volatile("global_store_dwordx4 %0, %1, off sc1\n\ts_nop 1" :: "v"(p), "v"(v) : "memory"); }
__device__ __forceinline__ unsigned pk2n(float lo, float hi) { unsigned r; asm volatile("v_cvt_pk_bf16_f32 %0, %1, %2\n\ts_nop 1" : "=v"(r) : "v"(lo), "v"(hi)); return r; }
__device__ __forceinline__ u32x4 lane_regroup(u32x4 w, int baddr) {
    u32x4 t; t.x = __builtin_amdgcn_ds_bpermute(baddr, w.x); t.y = __builtin_amdgcn_ds_bpermute(baddr, w.y); t.z = __builtin_amdgcn_ds_bpermute(baddr, w.z); t.w = __builtin_amdgcn_ds_bpermute(baddr, w.w); return t;
}
__device__ __forceinline__ float bflo(unsigned w) { return __uint_as_float(w << 16); }
__device__ __forceinline__ float bfhi(unsigned w) { return __uint_as_float(w & 0xffff0000u); }
__device__ __forceinline__ float fexp2(float x) { return __builtin_amdgcn_exp2f(x); }
__device__ __forceinline__ float frcp(float x) { return __builtin_amdgcn_rcpf(x); }
__device__ __forceinline__ float gelu_tanh(float x) { const float t = x * (1.0f + 0.044715f * x * x); return x * frcp(1.0f + fexp2(-GELU_K * t)); }
__device__ __forceinline__ float silu(float z) { return z * frcp(1.0f + fexp2(-LOG2E * z)); }
__device__ __forceinline__ float rstd_of(const float* part, int row) { const f32x4 p = *(const f32x4*)(part + (size_t)row * 4); return rsqrtf(((p[0] + p[1]) + (p[2] + p[3])) * (1.0f / DM) + EPS); }
__device__ __forceinline__ void load_rstd8(const float* part, int row0, float sc, float (&rsv)[8]) {
    f32x4 p[8];
#pragma unroll
    for (int e = 0; e < 8; ++e) p[e] = *(const f32x4*)(part + (size_t)(row0 + (e >> 2) * 128 + (e & 3) * 16) * 4);
    asm volatile("" : "+v"(p[0]), "+v"(p[1]), "+v"(p[2]), "+v"(p[3]), "+v"(p[4]), "+v"(p[5]), "+v"(p[6]), "+v"(p[7]));
#pragma unroll
    for (int e = 0; e < 8; ++e) rsv[e] = rsqrtf(((p[e][0] + p[e][1]) + (p[e][2] + p[e][3])) * (1.0f / DM) + EPS) * sc;
}
__device__ __forceinline__ float wave_sum(float v) {
#pragma unroll
    for (int o = 1; o < 64; o <<= 1) v += __shfl_xor(v, o);
    return v;
}

__device__ __forceinline__ int opaque_tid() { int t = threadIdx.x; asm volatile("" : "+v"(t)); return t; }
namespace pg8 {
#define PG8_LAS __attribute__((address_space(3)))
constexpr int BM = 256, BK = 64, HALF = 128, HTB = HALF * BK * 2, STAGE_BYTES = 8 * HTB, NXCD = 8, WGM = 8;
__host__ __device__ __forceinline__ int lds_byte(int r, int c) { const int st = (r >> 4) * 2 + (c >> 5), rr = r & 15, cc = c & 31, ob = rr * 64 + cc * 2; return st * 1024 + (ob ^ (((ob >> 9) & 1) << 5)); }
__host__ __device__ __forceinline__ void stage_rc(int b, int& R, int& C) { const int st = b / 1024, sb = b % 1024, swz = sb ^ (((sb >> 9) & 1) << 5); R = (st >> 1) * 16 + swz / 64; C = (st & 1) * 32 + (swz % 64) / 2; }
__host__ __device__ __forceinline__ int perm32(int rho) { const int n = rho >> 4, i = rho & 15; return 8 * (i >> 2) + 4 * n + (i & 3); }
struct Unit { int pm, pn; };
struct Gemm { const bf16_t* A; const bf16_t* Bt; int M, N, K; };
struct StaticOrder {
    int nM, nN, nwg, G, c;
    __host__ __device__ void init(int M, int N, int G_, int c_) { nM = M / BM; nN = N / BM; nwg = nM * nN; G = G_; c = c_; }
    __host__ __device__ bool next(int i, Unit& u) const {
        const long L = (long)i * G + c; if (L >= nwg) return false;
        int wgid = (int)L; { const int q = nwg / NXCD, r = nwg % NXCD, xcd = wgid % NXCD, off = wgid / NXCD; wgid = (xcd < r ? xcd * (q + 1) : r * (q + 1) + (xcd - r) * q) + off; }
        const int nig = WGM * nN, gid = wgid / nig, fm = gid * WGM, gsz = (nM - fm) < WGM ? (nM - fm) : WGM;
        u.pm = fm + ((wgid % nig) % gsz); u.pn = (wgid % nig) / gsz; return true;
    }
    __device__ __forceinline__ void a_ready(const Unit&) const {}
    __device__ __forceinline__ void done(const Unit&) const {}
};
template <class Epi, class Sched, bool ALIGN_EPI, bool SP2, bool PRE>
__device__ __forceinline__ void gemm_phase_impl(PG8_LAS unsigned char* lds, const Gemm g, const Sched& S, const Epi& E, const f32x4 (&pre)[2][2][4][2]) {
    const int tid = opaque_tid(), wid = __builtin_amdgcn_readfirstlane(tid >> 6), lane = tid & 63, wr = wid >> 2, wc = wid & 3, fr = lane & 15, fq = lane >> 4;
    const int K = g.K, nt = K / BK;
    unsigned voffA[2], voffB[2];
#pragma unroll
    for (int i = 0; i < 2; ++i) { int R, C; stage_rc(tid * 16 + i * 8192, R, C); const int Rb = Epi::PERM ? ((R & ~31) + perm32(R & 31)) : R;
        voffA[i] = (unsigned)(R * K + C) * 2u; voffB[i] = (unsigned)(Rb * K + C) * 2u; }
    const size_t kstep = (size_t)(BK * 2);
    const size_t hstep = (size_t)HALF * K * 2;
    const size_t tstep = 2 * hstep;
    const unsigned ldsw = (unsigned)wid * 1024u;
    const int aoff = lds_byte(wr * 64 + fr, fq * 8), boff = lds_byte(wc * 32 + fr, fq * 8);
#define PG8_SA(b, h) (((b) * 2 + (h)) * HTB)
#define PG8_SB(b, h) ((4 + (b) * 2 + (h)) * HTB)
#define PG8_STAGE(bufoff, gbase, voff) do { _Pragma("unroll") for (int _i = 0; _i < 2; ++_i) \
        __builtin_amdgcn_global_load_lds((const unsigned*)((const char*)(gbase) + (voff)[_i]), (PG8_LAS unsigned*)(lds + (bufoff) + ldsw + _i * 8192), 16, 0, 0); } while (0)
#define PG8_LDA(dst, b, h) do { _Pragma("unroll") for (int m = 0; m < 4; ++m) _Pragma("unroll") for (int k = 0; k < 2; ++k) dst[m][k] = *(const PG8_LAS bf16x8*)(lds + PG8_SA(b, h) + aoff + m * 2048 + k * 1024); } while (0)
#define PG8_LDB(dst, b, h) do { _Pragma("unroll") for (int n = 0; n < 2; ++n) _Pragma("unroll") for (int k = 0; k < 2; ++k) dst[n][k] = *(const PG8_LAS bf16x8*)(lds + PG8_SB(b, h) + boff + n * 2048 + k * 1024); } while (0)
#define PG8_MMA(ai, bj, At, Bt) do { __builtin_amdgcn_s_setprio(1); _Pragma("unroll") for (int m = 0; m < 4; ++m) _Pragma("unroll") for (int n = 0; n < 2; ++n) _Pragma("unroll") for (int k = 0; k < 2; ++k) \
        acc[ai][bj][m][n] = __builtin_amdgcn_mfma_f32_16x16x32_bf16(Bt[n][k], At[m][k], acc[ai][bj][m][n], 0, 0, 0); __builtin_amdgcn_s_setprio(0); } while (0)
#define PG8_WAIT_V(n) asm volatile("s_waitcnt vmcnt(" #n ")" ::: "memory")
#define PG8_WAIT_L(n) asm volatile("s_waitcnt lgkmcnt(" #n ")" ::: "memory")
#define PG8_BAR __builtin_amdgcn_s_barrier()
#define PG8_SCHED __builtin_amdgcn_sched_barrier(0)
    Unit cur, nxt; int ui = 0;
    if (!S.next(0, cur)) return;
    f32x4 acc[2][2][4][2];
    if constexpr (Epi::INIT) {
        if constexpr (PRE) {
#pragma unroll
            for (int a = 0; a < 2; ++a)
#pragma unroll
                for (int b = 0; b < 2; ++b)
#pragma unroll
                    for (int m = 0; m < 4; ++m)
#pragma unroll
                        for (int n = 0; n < 2; ++n) acc[a][b][m][n] = pre[a][b][m][n];
        } else E.init(acc, cur, wr, wc, fr, fq);
    }
    else {
#pragma unroll
    for (int a = 0; a < 2; ++a)
#pragma unroll
        for (int b = 0; b < 2; ++b)
#pragma unroll
            for (int m = 0; m < 4; ++m)
#pragma unroll
                for (int n = 0; n < 2; ++n) acc[a][b][m][n] = (f32x4){0.f, 0.f, 0.f, 0.f};
    }
    bf16x8 At[4][2], B0[2][2], B1[2][2];
    const char* cA = (const char*)g.A + (size_t)cur.pm * tstep; const char* cB = (const char*)g.Bt + (size_t)cur.pn * tstep;
    S.a_ready(cur);
    if constexpr (SP2) {
        PG8_STAGE(PG8_SB(0, 0), cB, voffB); PG8_STAGE(PG8_SB(0, 1), cB + hstep, voffB); PG8_STAGE(PG8_SA(0, 0), cA, voffA); PG8_STAGE(PG8_SA(0, 1), cA + hstep, voffA);
        if (wr == 1) PG8_BAR;
        PG8_WAIT_V(2); PG8_BAR;
        PG8_STAGE(PG8_SB(1, 0), cB + kstep, voffB); PG8_STAGE(PG8_SA(1, 0), cA + kstep, voffA); PG8_STAGE(PG8_SB(1, 1), cB + hstep + kstep, voffB);
        PG8_WAIT_V(6); PG8_BAR;
    } else {
        PG8_STAGE(PG8_SB(0, 0), cB, voffB); PG8_STAGE(PG8_SA(0, 0), cA, voffA); PG8_STAGE(PG8_SB(0, 1), cB + hstep, voffB); PG8_STAGE(PG8_SA(0, 1), cA + hstep, voffA);
        if (wr == 1) PG8_BAR;
        PG8_WAIT_V(4); PG8_BAR;
        PG8_STAGE(PG8_SB(1, 0), cB + kstep, voffB); PG8_STAGE(PG8_SA(1, 0), cA + kstep, voffA); PG8_STAGE(PG8_SB(1, 1), cB + hstep + kstep, voffB);
        PG8_WAIT_V(6); PG8_BAR;
    }
    for (;;) {
        const bool has_next = S.next(ui + 1, nxt);
        const char* nA = has_next ? (const char*)g.A + (size_t)nxt.pm * tstep : cA; const char* nB = has_next ? (const char*)g.Bt + (size_t)nxt.pn * tstep : cB;
        for (int t = 0; t < nt; t += 2) {
            const bool last = (t == nt - 2);
            const char* a1 = cA + (size_t)(t + 1) * kstep;
            const char* a2 = last ? nA : cA + (size_t)(t + 2) * kstep; const char* b2 = last ? nB : cB + (size_t)(t + 2) * kstep;
            const char* a3 = a2 + kstep; const char* b3 = b2 + kstep;
            if (last && has_next) S.a_ready(nxt);
            if constexpr (SP2) {
            PG8_LDB(B0, 0, 0); PG8_LDB(B1, 0, 1); PG8_SCHED; PG8_LDA(At, 0, 0); PG8_STAGE(PG8_SA(1, 1), a1 + hstep, voffA);
            PG8_WAIT_V(8); PG8_WAIT_L(0); PG8_BAR; PG8_MMA(0, 0, At, B0); PG8_MMA(0, 1, At, B1); PG8_BAR; PG8_SCHED;
            PG8_LDA(At, 0, 1); PG8_STAGE(PG8_SB(0, 0), b2, voffB); PG8_STAGE(PG8_SB(0, 1), b2 + hstep, voffB); PG8_STAGE(PG8_SA(0, 0), a2, voffA);
            PG8_WAIT_V(8); PG8_WAIT_L(0); PG8_BAR; PG8_MMA(1, 0, At, B0); PG8_MMA(1, 1, At, B1); PG8_BAR; PG8_SCHED;
            PG8_LDB(B0, 1, 0); PG8_LDB(B1, 1, 1); PG8_SCHED; PG8_LDA(At, 1, 0); PG8_STAGE(PG8_SA(0, 1), a2 + hstep, voffA);
            PG8_WAIT_V(8); PG8_WAIT_L(0); PG8_BAR; PG8_MMA(0, 0, At, B0); PG8_MMA(0, 1, At, B1); PG8_BAR; PG8_SCHED;
            PG8_LDA(At, 1, 1); PG8_STAGE(PG8_SB(1, 0), b3, voffB); PG8_STAGE(PG8_SB(1, 1), b3 + hstep, voffB); PG8_STAGE(PG8_SA(1, 0), a3, voffA);
            PG8_WAIT_V(8); PG8_WAIT_L(0); PG8_BAR; PG8_MMA(1, 0, At, B0); PG8_MMA(1, 1, At, B1); PG8_BAR; PG8_SCHED;
            } else {
            PG8_LDB(B0, 0, 0); PG8_SCHED; PG8_LDA(At, 0, 0); PG8_STAGE(PG8_SA(1, 1), a1 + hstep, voffA);
            PG8_WAIT_L(8); PG8_BAR; PG8_WAIT_L(0); PG8_MMA(0, 0, At, B0); PG8_BAR; PG8_SCHED;
            PG8_LDB(B1, 0, 1); PG8_STAGE(PG8_SB(0, 0), b2, voffB);
            PG8_BAR; PG8_WAIT_L(0); PG8_MMA(0, 1, At, B1); PG8_BAR;
            PG8_LDA(At, 0, 1); PG8_STAGE(PG8_SA(0, 0), a2, voffA);
            PG8_BAR; PG8_WAIT_L(0); PG8_MMA(1, 0, At, B0); PG8_BAR; PG8_SCHED;
            PG8_STAGE(PG8_SB(0, 1), b2 + hstep, voffB);
            PG8_WAIT_V(6); PG8_BAR; PG8_MMA(1, 1, At, B1); PG8_BAR;
            PG8_LDB(B0, 1, 0); PG8_SCHED; PG8_LDA(At, 1, 0); PG8_STAGE(PG8_SA(0, 1), a2 + hstep, voffA);
            PG8_WAIT_L(8); PG8_BAR; PG8_WAIT_L(0); PG8_MMA(0, 0, At, B0); PG8_BAR; PG8_SCHED;
            PG8_LDB(B1, 1, 1); PG8_STAGE(PG8_SB(1, 0), b3, voffB);
            PG8_BAR; PG8_WAIT_L(0); PG8_MMA(0, 1, At, B1); PG8_BAR;
            PG8_LDA(At, 1, 1); PG8_STAGE(PG8_SA(1, 0), a3, voffA);
            PG8_BAR; PG8_WAIT_L(0); PG8_MMA(1, 0, At, B0); PG8_BAR; PG8_SCHED;
            PG8_STAGE(PG8_SB(1, 1), b3 + hstep, voffB);
            PG8_WAIT_V(6); PG8_BAR; PG8_MMA(1, 1, At, B1); PG8_BAR;
            }
        }
        if constexpr (ALIGN_EPI) { if (wr == 0) PG8_BAR; }
        if constexpr (!Epi::AFTER_DRAIN) { E(acc, cur, wr, wc, fr, fq); S.done(cur); }
        if (!has_next) break;
#pragma unroll
        for (int a = 0; a < 2; ++a)
#pragma unroll
            for (int b = 0; b < 2; ++b)
#pragma unroll
                for (int m = 0; m < 4; ++m)
#pragma unroll
                    for (int n = 0; n < 2; ++n) acc[a][b][m][n] = (f32x4){0.f, 0.f, 0.f, 0.f};
        cur = nxt; cA = nA; cB = nB; ++ui;
        if constexpr (ALIGN_EPI) { if (wr == 1) PG8_BAR; }
    }
    PG8_WAIT_V(0);
    if constexpr (!ALIGN_EPI) { if (wr == 0) PG8_BAR; }
    PG8_BAR;
    if constexpr (Epi::AFTER_DRAIN) { E.fused(acc, cur, wr, wc, fr, fq, lds, wid, lane); S.done(cur); }
#undef PG8_SA
#undef PG8_SB
#undef PG8_STAGE
#undef PG8_LDA
#undef PG8_LDB
#undef PG8_MMA
#undef PG8_WAIT_V
#undef PG8_WAIT_L
#undef PG8_BAR
#undef PG8_SCHED
}
template <class Epi, class Sched, bool ALIGN_EPI = false, bool SP2 = false>
__device__ __forceinline__ void gemm_phase(PG8_LAS unsigned char* lds, const Gemm g, const Sched& S, const Epi& E) { f32x4 none[2][2][4][2]; gemm_phase_impl<Epi, Sched, ALIGN_EPI, SP2, false>(lds, g, S, E, none); }
template <class Epi, class Sched, bool ALIGN_EPI = false, bool SP2 = false>
__device__ __forceinline__ void gemm_phase_pre(PG8_LAS unsigned char* lds, const Gemm g, const Sched& S, const Epi& E, const f32x4 (&pre)[2][2][4][2]) { gemm_phase_impl<Epi, Sched, ALIGN_EPI, SP2, true>(lds, g, S, E, pre); }
}

struct EpiUZ {
    static constexpr bool PERM = true, AFTER_DRAIN = false, INIT = false;
    bf16_t* GUZ; const float* part;
    __device__ __forceinline__ void operator()(const f32x4 (&acc)[2][2][4][2], const pg8::Unit& u, int wr, int wc, int fr, int fq) const {
        const int row0 = u.pm * 256 + wr * 64 + fr, col0 = u.pn * 128 + wc * 32 + 8 * fq;
        float rsv[8]; load_rstd8(part, row0, 1.0f, rsv);
        const int L_ = fr + 16 * fq, baddr = 4 * ((L_ >> 2) + 16 * (L_ & 3)), rowp0 = u.pm * 256 + wr * 64 + (L_ >> 2), colp0 = u.pn * 128 + wc * 32 + 8 * (L_ & 3);
#pragma unroll
        for (int ai = 0; ai < 2; ++ai)
#pragma unroll
            for (int m = 0; m < 4; ++m) {
                const int row = row0 + ai * 128 + m * 16; const float rs = rsv[ai * 4 + m];
                float o[8];
#pragma unroll
                for (int n = 0; n < 2; ++n) {
                    const f32x4 uu = acc[ai][0][m][n] * rs, zz = acc[ai][1][m][n] * rs;
                    const f32x4 ea = uu * (uu * uu * (-0.044715f * GELU_K) + (-GELU_K)), eb = acc[ai][1][m][n] * (rs * -LOG2E);
                    f32x4 xa, xb;
#pragma unroll
                    for (int j = 0; j < 4; ++j) { xa[j] = fexp2(ea[j]); xb[j] = fexp2(eb[j]); }
                    const f32x4 den = (xa + 1.0f) * (xb + 1.0f), num = uu * zz;
#pragma unroll
                    for (int j = 0; j < 4; ++j) o[n * 4 + j] = num[j] * frcp(den[j]);
                }
                u32x4 w; w.x = pk2(o[0], o[1]); w.y = pk2(o[2], o[3]); w.z = pk2(o[4], o[5]); w.w = pk2(o[6], o[7]);
                store16_wt(GUZ + (size_t)(rowp0 + ai * 128 + m * 16) * DI + colp0, lane_regroup(w, baddr));
            }
    }
};
template <int ACT> struct EpiT {
    static constexpr bool PERM = true, AFTER_DRAIN = false, INIT = false;
    bf16_t* OT; const float* part; float* lnpart;
    __device__ __forceinline__ void operator()(const f32x4 (&acc)[2][2][4][2], const pg8::Unit& u, int wr, int wc, int fr, int fq) const {
        const int frow0 = u.pm * 256 + wr * 64 + fr;
#pragma unroll
        for (int bj = 0; bj < 2; ++bj) {
            const int tok0 = u.pn * 256 + bj * 128 + wc * 32 + 8 * fq;
            const int L_ = fr + 16 * fq, baddr = 4 * ((L_ >> 2) + 16 * (L_ & 3)), frowp0 = u.pm * 256 + wr * 64 + (L_ >> 2), tokp0 = u.pn * 256 + bj * 128 + wc * 32 + 8 * (L_ & 3);
            float rs[8], s[8], q[8];
#pragma unroll
            for (int e = 0; e < 8; ++e) { rs[e] = rstd_of(part, tok0 + e); s[e] = 0.f; q[e] = 0.f; }
#pragma unroll
            for (int ai = 0; ai < 2; ++ai)
#pragma unroll
                for (int m = 0; m < 4; ++m) {
                    float o[8];
#pragma unroll
                    for (int n = 0; n < 2; ++n)
#pragma unroll
                        for (int j = 0; j < 4; ++j) { float v = acc[ai][bj][m][n][j] * rs[n * 4 + j]; if (ACT == 1) { v = gelu_tanh(v); s[n * 4 + j] += v; q[n * 4 + j] += v * v; } o[n * 4 + j] = v; }
                    u32x4 w; w.x = pk2(o[0], o[1]); w.y = pk2(o[2], o[3]); w.z = pk2(o[4], o[5]); w.w = pk2(o[6], o[7]);
                    store16_wt(OT + (size_t)(frowp0 + ai * 128 + m * 16) * MT + tokp0, lane_regroup(w, baddr));
                }
            if (ACT == 1) {
#pragma unroll
                for (int e = 0; e < 8; ++e) {
#pragma unroll
                    for (int o = 1; o < 16; o <<= 1) { s[e] += __shfl_xor(s[e], o); q[e] += __shfl_xor(q[e], o); }
                    if (fr == 0) *(f32x2*)(lnpart + (size_t)(tok0 + e) * 32 + (u.pm * 2 + wr) * 2) = (f32x2){s[e], q[e]};
                }
            }
        }
    }
};
struct EpiRS {
    static constexpr bool PERM = true, AFTER_DRAIN = false, INIT = false;
    bf16_t* O0; long long d1, d2; float qs; int qreg, zreg; const float* part;
    __device__ __forceinline__ void operator()(const f32x4 (&acc)[2][2][4][2], const pg8::Unit& u, int wr, int wc, int fr, int fq) const {
        const int reg = u.pn >> 3; bf16_t* O = (bf16_t*)((char*)O0 + (reg == 1 ? d1 : 0ll) + (reg == 2 ? d2 : 0ll)); const float sc = (reg == qreg) ? qs : 1.0f; const bool act = (reg == zreg);
        const int row0 = u.pm * 256 + wr * 64 + fr, col0 = (u.pn & 7) * 256 + wc * 32 + 8 * fq;
        float rsv[8]; load_rstd8(part, row0, sc, rsv);
        const int L_ = fr + 16 * fq, baddr = 4 * ((L_ >> 2) + 16 * (L_ & 3)), rowp0 = u.pm * 256 + wr * 64 + (L_ >> 2), colp0 = (u.pn & 7) * 256 + wc * 32 + 8 * (L_ & 3);
#pragma unroll
        for (int ai = 0; ai < 2; ++ai)
#pragma unroll
            for (int m = 0; m < 4; ++m) {
                const int row = row0 + ai * 128 + m * 16; const float rs = rsv[ai * 4 + m];
#pragma unroll
                for (int bj = 0; bj < 2; ++bj) {
                    f32x4 v0 = acc[ai][bj][m][0] * rs, v1 = acc[ai][bj][m][1] * rs;
                    if (act) {
#pragma unroll
                        for (int j = 0; j < 4; ++j) { v0[j] = silu(v0[j]); v1[j] = silu(v1[j]); }
                    }
                    u32x4 w; w.x = pk2(v0[0], v0[1]); w.y = pk2(v0[2], v0[3]); w.z = pk2(v1[0], v1[1]); w.w = pk2(v1[2], v1[3]);
                    u32x4 t; t.x = __builtin_amdgcn_ds_bpermute(baddr, w.x); t.y = __builtin_amdgcn_ds_bpermute(baddr, w.y); t.z = __builtin_amdgcn_ds_bpermute(baddr, w.z); t.w = __builtin_amdgcn_ds_bpermute(baddr, w.w);
                    store16_wt(O + (size_t)(rowp0 + ai * 128 + m * 16) * DI + colp0 + bj * 128, t);
                }
            }
    }
};
struct EpiOut {
    static constexpr bool PERM = true, AFTER_DRAIN = true, INIT = true;
    const float* xin32; bf16_t* XB; float* part;
    float* fout; const float* fgain; unsigned* cnt;
    __device__ __forceinline__ void init(f32x4 (&acc)[2][2][4][2], const pg8::Unit& u, int wr, int wc, int fr, int fq) const {
        const int row0 = u.pm * 256 + wr * 64 + fr, col0 = u.pn * 256 + wc * 32 + 8 * fq;
#pragma unroll
        for (int ai = 0; ai < 2; ++ai)
#pragma unroll
            for (int m = 0; m < 4; ++m)
#pragma unroll
                for (int bj = 0; bj < 2; ++bj) {
                    const size_t off = (size_t)(row0 + ai * 128 + m * 16) * DM + col0 + bj * 128;
                    if (xin32) { acc[ai][bj][m][0] = *(const f32x4*)(xin32 + off); acc[ai][bj][m][1] = *(const f32x4*)(xin32 + off + 4); }
                    else { const u32x4 r = *(const u32x4*)(XB + off); acc[ai][bj][m][0] = (f32x4){bflo(r.x), bfhi(r.x), bflo(r.y), bfhi(r.y)}; acc[ai][bj][m][1] = (f32x4){bflo(r.z), bfhi(r.z), bflo(r.w), bfhi(r.w)}; }
                }
    }
    __device__ __forceinline__ void fused(f32x4 (&acc)[2][2][4][2], const pg8::Unit& u, int wr, int wc, int fr, int fq, PG8_LAS unsigned char* lds, int wid, int lane) const {
        PG8_LAS float* P = (PG8_LAS float*)lds;
        const int row0 = u.pm * 256 + wr * 64 + fr, col0 = u.pn * 256 + wc * 32 + 8 * fq;
        const int L_ = fr + 16 * fq, baddr = 4 * ((L_ >> 2) + 16 * (L_ & 3)), rowp0 = u.pm * 256 + wr * 64 + (L_ >> 2), colp0 = u.pn * 256 + wc * 32 + 8 * (L_ & 3);
#pragma unroll
        for (int ai = 0; ai < 2; ++ai)
#pragma unroll
            for (int m = 0; m < 4; ++m) {
                const int row = row0 + ai * 128 + m * 16; float ss = 0.f;
#pragma unroll
                for (int bj = 0; bj < 2; ++bj) {
                    const size_t off = (size_t)row * DM + col0 + bj * 128;
                    const f32x4 v0 = acc[ai][bj][m][0], v1 = acc[ai][bj][m][1];
                    u32x4 w; w.x = pk2(v0[0], v0[1]); w.y = pk2(v0[2], v0[3]); w.z = pk2(v1[0], v1[1]); w.w = pk2(v1[2], v1[3]);
                    if (!fout) *(u32x4*)(XB + (size_t)(rowp0 + ai * 128 + m * 16) * DM + colp0 + bj * 128) = lane_regroup(w, baddr);
                    ss += (v0[0] * v0[0] + v0[1] * v0[1]) + (v0[2] * v0[2] + v0[3] * v0[3]) + (v1[0] * v1[0] + v1[1] * v1[1]) + (v1[2] * v1[2] + v1[3] * v1[3]);
                }
                ss += __shfl_xor(ss, 16); ss += __shfl_xor(ss, 32);
                if (fq == 0) P[(ai * 128 + wr * 64 + m * 16 + fr) * 4 + wc] = ss;
            }
        __syncthreads();
        const int t256 = wid * 64 + lane;
        if (!fout) {
            if (t256 < 256) { const f32x4 p = *(const PG8_LAS f32x4*)(P + t256 * 4); part[(size_t)(u.pm * 256 + t256) * 4 + u.pn] = (p[0] + p[1]) + (p[2] + p[3]); }
            __syncthreads();
            return;
        }
        PG8_LAS float* RSv = (PG8_LAS float*)(lds + 4096);
        if (t256 < 256) { const f32x4 p = *(const PG8_LAS f32x4*)(P + t256 * 4); __hip_atomic_store(part + (size_t)(u.pm * 256 + t256) * 4 + u.pn, (p[0] + p[1]) + (p[2] + p[3]), __ATOMIC_RELAXED, __HIP_MEMORY_SCOPE_AGENT); }
        asm volatile("s_waitcnt vmcnt(0)" ::: "memory");
        __syncthreads();
        if (wid == 0) {
            if (lane == 0) __hip_atomic_fetch_add(cnt + 16 * u.pm, 1u, __ATOMIC_RELAXED, __HIP_MEMORY_SCOPE_AGENT);
            unsigned sp = 0;
            while ((unsigned)__builtin_amdgcn_readfirstlane(__hip_atomic_load(cnt + 16 * u.pm, __ATOMIC_RELAXED, __HIP_MEMORY_SCOPE_AGENT)) < 4u) { __builtin_amdgcn_s_sleep(2); if (++sp > (1u << 20)) break; }
            __builtin_amdgcn_fence(__ATOMIC_ACQUIRE, "agent");
            asm volatile("s_waitcnt vmcnt(0)" ::: "memory");
        }
        __syncthreads();
        if (t256 < 256) {
            const float* pp = part + (size_t)(u.pm * 256 + t256) * 4; float s4 = 0.f;
#pragma unroll
            for (int t = 0; t < 4; ++t) s4 += __hip_atomic_load(pp + t, __ATOMIC_RELAXED, __HIP_MEMORY_SCOPE_AGENT);
            RSv[t256] = rsqrtf(s4 * (1.0f / DM) + EPS);
        }
        __syncthreads();
        f32x4 gn[2][2];
#pragma unroll
        for (int bj = 0; bj < 2; ++bj) { gn[bj][0] = *(const f32x4*)(fgain + col0 + bj * 128); gn[bj][1] = *(const f32x4*)(fgain + col0 + bj * 128 + 4); }
#pragma unroll
        for (int ai = 0; ai < 2; ++ai)
#pragma unroll
            for (int m = 0; m < 4; ++m) {
                const int rl = ai * 128 + wr * 64 + m * 16 + fr; const float rs = RSv[rl];
#pragma unroll
                for (int bj = 0; bj < 2; ++bj) {
                    const size_t off = (size_t)(u.pm * 256 + rl) * DM + col0 + bj * 128;
                    *(f32x4*)(fout + off) = acc[ai][bj][m][0] * rs * gn[bj][0]; *(f32x4*)(fout + off + 4) = acc[ai][bj][m][1] * rs * gn[bj][1];
                }
            }
    }
};

struct Ptrs {
    const float *x, *a_norm, *a_w_in, *a_ln_g, *a_ln_b, *a_w_s, *a_b_s, *a_w_out, *kv_norm, *w_kv, *b_norm, *b_w_in, *b_w_out, *final_norm;
    float* out; unsigned char* ws;
};
__device__ __forceinline__ void p0_item(const float* W, int N, int K, int k0, int n0, const float* gain, bf16_t* dst, LAS float* scr, int lane) {
    f32x4 wv[8];
#pragma unroll
    for (int i = 0; i < 8; ++i) wv[i] = __builtin_nontemporal_load((const f32x4*)(W + (size_t)(k0 + 8 * i + (lane >> 3)) * N + n0 + 4 * (lane & 7)));
#pragma unroll
    for (int i = 0; i < 8; ++i)
#pragma unroll
        for (int j = 0; j < 4; ++j) scr[(8 * i + (lane >> 3)) * 33 + 4 * (lane & 7) + j] = wv[i][j];
    asm volatile("s_waitcnt lgkmcnt(0)" ::: "memory");
    const int c = lane & 7;
    float gv[8];
    { const f32x4 g0 = gain ? *(const f32x4*)(gain + k0 + 8 * c) : (f32x4){1.f, 1.f, 1.f, 1.f}, g1 = gain ? *(const f32x4*)(gain + k0 + 8 * c + 4) : (f32x4){1.f, 1.f, 1.f, 1.f};
#pragma unroll
      for (int e = 0; e < 4; ++e) { gv[e] = g0[e]; gv[4 + e] = g1[e]; } }
#pragma unroll
    for (int j = 0; j < 4; ++j) { const int n = (lane >> 3) + 8 * j; const LAS float* s = scr + (8 * c) * 33 + n;
        u32x4 o; o.x = pk2(s[0 * 33] * gv[0], s[1 * 33] * gv[1]); o.y = pk2(s[2 * 33] * gv[2], s[3 * 33] * gv[3]); o.z = pk2(s[4 * 33] * gv[4], s[5 * 33] * gv[5]); o.w = pk2(s[6 * 33] * gv[6], s[7 * 33] * gv[7]);
        *(u32x4*)(dst + (size_t)n * K + k0 + 8 * c) = o; }
    asm volatile("s_waitcnt lgkmcnt(0)" ::: "memory");
}
__device__ __forceinline__ void phase0(const Ptrs& P, LAS unsigned char* lds, int G) {
    const int tid = opaque_tid(), lane = tid & 63, wave = tid >> 6;
    LAS float* scr = (LAS float*)(lds + wave * 8704);
    bf16_t* WA = (bf16_t*)(P.ws + WS_R2); bf16_t* WB = (bf16_t*)(P.ws + WS_WB);
    const int gw = blockIdx.x * 8 + wave, NGW = G * 8;
    for (int it = gw; it < 16384; it += NGW) {
        int r = it; const float* W; int N, K; const float* gain; int seg;
        if (r < 6144) { seg = r / 3072; r -= seg * 3072; W = P.a_w_in + (size_t)seg * DM * 6144; N = 6144; K = DM; gain = P.a_norm + seg * DM;
            const int nblk = N / 32, kb = r / nblk, n0 = (r % nblk) * 32; bf16_t* dst;
            if (n0 < 2048) dst = WA + seg * WA_LAYER + WA_UZ + (size_t)(256 * (n0 >> 7) + (n0 & 127)) * K;
            else if (n0 < 4096) dst = WA + seg * WA_LAYER + WA_V + (size_t)(n0 - 2048) * K;
            else { const int f = n0 - 4096; dst = WA + seg * WA_LAYER + WA_UZ + (size_t)(256 * (f >> 7) + 128 + (f & 127)) * K; }
            p0_item(W, N, K, kb * 64, n0, gain, dst, scr, lane); continue; }
        r -= 6144;
        if (r < 2048) { seg = r / 1024; r -= seg * 1024; W = P.a_w_out + (size_t)seg * DI * DM; N = DM; K = DI;
            const int nblk = N / 32, kb = r / nblk, n0 = (r % nblk) * 32;
            p0_item(W, N, K, kb * 64, n0, nullptr, WA + seg * WA_LAYER + WA_OUT + (size_t)n0 * K, scr, lane); continue; }
        r -= 2048;
        if (r < 2048) { W = P.w_kv; N = 4096; K = DM;
            const int nblk = N / 32, kb = r / nblk, n0 = (r % nblk) * 32;
            bf16_t* dst = (n0 < 2048) ? WB + WB_K + (size_t)n0 * K : WB + WB_VV + (size_t)(n0 - 2048) * K;
            p0_item(W, N, K, kb * 64, n0, P.kv_norm, dst, scr, lane); continue; }
        r -= 2048;
        if (r < 4096) { seg = r / 2048; r -= seg * 2048; W = P.b_w_in + (size_t)seg * DM * 4096; N = 4096; K = DM;
            const int nblk = N / 32, kb = r / nblk, n0 = (r % nblk) * 32;
            bf16_t* dst = (n0 < 2048) ? WB + (seg ? WB_Q1 : WB_Q0) + (size_t)n0 * K : WB + (seg ? WB_Z1 : WB_Z0) + (size_t)(n0 - 2048) * K;
            p0_item(W, N, K, kb * 64, n0, P.b_norm + seg * DM, dst, scr, lane); continue; }
        r -= 4096;
        { seg = r / 1024; r -= seg * 1024; W = P.b_w_out + (size_t)seg * DI * DM; N = DM; K = DI;
            const int nblk = N / 32, kb = r / nblk, n0 = (r % nblk) * 32;
            p0_item(W, N, K, kb * 64, n0, nullptr, WB + (seg ? WB_OUT1 : WB_OUT0) + (size_t)n0 * K, scr, lane); }
    }
    bf16_t* XB = (bf16_t*)(P.ws + WS_XB);
    for (int row = gw; row < MT; row += NGW) {
        const f32x4* xr = (const f32x4*)(P.x + (size_t)row * DM) + lane; f32x4 v[4]; float ss = 0.f;
#pragma unroll
        for (int j = 0; j < 4; ++j) { v[j] = __builtin_nontemporal_load(xr + 64 * j); ss += (v[j][0] * v[j][0] + v[j][1] * v[j][1]) + (v[j][2] * v[j][2] + v[j][3] * v[j][3]); }
        ss = wave_sum(ss);
        u32x2* o = (u32x2*)(XB + (size_t)row * DM) + lane;
#pragma unroll
        for (int j = 0; j < 4; ++j) o[64 * j] = (u32x2){pk2(v[j][0], v[j][1]), pk2(v[j][2], v[j][3])};
        if (lane == 0) *(f32x4*)(g_part + (size_t)row * 4) = (f32x4){ss, 0.f, 0.f, 0.f};
    }
    for (int i = blockIdx.x * 512 + tid; i < 2 * 8 * 128 * 128 / 2; i += G * 512) {
        const int e = 2 * i, s = e & 127, t = (e >> 7) & 127;
        const f32x2 w = *(const f32x2*)(P.a_w_s + e); const bool keep = (s >> 6) <= (t >> 6);
        *(unsigned*)(g_wsm + e) = keep ? pk2(w[0], w[1]) : 0u;
    }
}

__device__ __forceinline__ void phaseA2(const Ptrs& P, int layer, LAS unsigned char* lds, int G, bf16_t* YD) {
    const int tid = opaque_tid(), lane = tid & 63, wave = tid >> 6;
    LAS unsigned char* VN = lds;
    LAS unsigned char* WM = lds + 65536;
    LAS float* MU = (LAS float*)(lds + 98304);
    LAS float* RS = MU + 128;
    bf16_t* GUZ = (bf16_t*)(P.ws + WS_R0); const bf16_t* GVT = (const bf16_t*)(P.ws + WS_R1);
    const float* lg = P.a_ln_g + layer * DI; const float* lb = P.a_ln_b + layer * DI; const float* bs = P.a_b_s + layer * 8 * 128;
    u32x4 raw[8];
    {   const int u0 = blockIdx.x, nb0 = u0 >> 3, g0 = u0 & 7;
        if (u0 < 1024) {
#pragma unroll
            for (int j = 0; j < 8; ++j) { const int q = tid + 512 * j, c = q >> 4, cc = q & 15; raw[j] = *(const u32x4*)(GVT + (size_t)(g0 * 256 + c) * MT + nb0 * 128 + 8 * cc); }
        }
    }
    const int r = lane & 15, kg = lane >> 4;
    for (int u = blockIdx.x; u < 1024; u += G) {
        const int nb = u >> 3, g = u & 7;
        u32x4 wreg[4];
#pragma unroll
        for (int j = 0; j < 4; ++j) { const int q = tid + 512 * j, t = q >> 4, cc = q & 15; wreg[j] = *(const u32x4*)(g_wsm + (size_t)(layer * 8 + g) * 16384 + t * 128 + 8 * cc); }
        if (tid < 128) {
            const f32x4* lp = (const f32x4*)(g_lnpart + (size_t)(nb * 128 + tid) * 32); float s = 0.f, q = 0.f;
#pragma unroll
            for (int j = 0; j < 8; ++j) { const f32x4 v = lp[j]; s += v[0] + v[2]; q += v[1] + v[3]; }
            const float mu = s * (1.0f / DI), var = q * (1.0f / DI) - mu * mu;
            MU[tid] = mu; RS[tid] = rsqrtf(fmaxf(var, 0.f) + EPS);
        }
        __syncthreads();
        const int foff = 8 * (kg >> 1) + 16 * (kg & 1);
        u32x4 gq[8];
#pragma unroll
        for (int nt = 0; nt < 8; ++nt) gq[nt] = *(const u32x4*)(GUZ + (size_t)(nb * 128 + nt * 16 + r) * DI + g * 256 + wave * 32 + foff);
        float bsr[8];
#pragma unroll
        for (int nt = 0; nt < 8; ++nt) bsr[nt] = bs[g * 128 + nt * 16 + r];
        asm volatile("" : "+v"(bsr[0]), "+v"(bsr[1]), "+v"(bsr[2]), "+v"(bsr[3]), "+v"(bsr[4]), "+v"(bsr[5]), "+v"(bsr[6]), "+v"(bsr[7]));
#pragma unroll
        for (int j = 0; j < 8; ++j) {
            const int q = tid + 512 * j, c = q >> 4, cc = q & 15; const int f = g * 256 + c;
            const float gg = lg[f], bb = lb[f];
            const f32x4 m0 = *(const LAS f32x4*)(MU + 8 * cc), m1 = *(const LAS f32x4*)(MU + 8 * cc + 4), r0 = *(const LAS f32x4*)(RS + 8 * cc), r1 = *(const LAS f32x4*)(RS + 8 * cc + 4);
            u32x4 w;
            w.x = pk2((bflo(raw[j].x) - m0[0]) * r0[0] * gg + bb, (bfhi(raw[j].x) - m0[1]) * r0[1] * gg + bb);
            w.y = pk2((bflo(raw[j].y) - m0[2]) * r0[2] * gg + bb, (bfhi(raw[j].y) - m0[3]) * r0[3] * gg + bb);
            w.z = pk2((bflo(raw[j].z) - m1[0]) * r1[0] * gg + bb, (bfhi(raw[j].z) - m1[1]) * r1[1] * gg + bb);
            w.w = pk2((bflo(raw[j].w) - m1[2]) * r1[2] * gg + bb, (bfhi(raw[j].w) - m1[3]) * r1[3] * gg + bb);
            *(LAS u32x4*)(VN + c * 256 + ((cc ^ (c & 15)) << 4)) = w;
        }
#pragma unroll
        for (int j = 0; j < 4; ++j) { const int q = tid + 512 * j, t = q >> 4, cc = q & 15; *(LAS u32x4*)(WM + t * 256 + ((cc ^ (t & 15)) << 4)) = wreg[j]; }
        __syncthreads();
        {   const int un = u + G;
            if (un < 1024) { const int nbn = un >> 3, gn = un & 7;
#pragma unroll
                for (int j = 0; j < 8; ++j) { const int q = tid + 512 * j, c = q >> 4, cc = q & 15; raw[j] = *(const u32x4*)(GVT + (size_t)(gn * 256 + c) * MT + nbn * 128 + 8 * cc); } }
        }
        f32x4 acc[2][8];
#pragma unroll
        for (int a = 0; a < 2; ++a)
#pragma unroll
            for (int b = 0; b < 8; ++b) acc[a][b] = (f32x4){0.f, 0.f, 0.f, 0.f};
#pragma unroll
        for (int ks = 0; ks < 4; ++ks) {
            bf16x8 va[2];
#pragma unroll
            for (int ct = 0; ct < 2; ++ct) { const int c = wave * 32 + ct * 16 + r; va[ct] = *(const LAS bf16x8*)(VN + c * 256 + (((4 * ks + kg) ^ (c & 15)) << 4)); }
#pragma unroll
            for (int nt = 0; nt < 8; ++nt) { const int t = nt * 16 + r; const bf16x8 wb = *(const LAS bf16x8*)(WM + t * 256 + (((4 * ks + kg) ^ (t & 15)) << 4));
#pragma unroll
                for (int ct = 0; ct < 2; ++ct) acc[ct][nt] = __builtin_amdgcn_mfma_f32_16x16x32_bf16(va[ct], wb, acc[ct][nt], 0, 0, 0); }
        }
#pragma unroll
        for (int nt = 0; nt < 8; ++nt) {
            const int t = nt * 16 + r; const float bias = bsr[nt];
            u32x4 gz = gq[nt];
            { auto r0 = __builtin_amdgcn_permlane16_swap(gz.x, gz.z, false, false); gz.x = r0[0]; gz.z = r0[1]; auto r1 = __builtin_amdgcn_permlane16_swap(gz.y, gz.w, false, false); gz.y = r1[0]; gz.w = r1[1]; }
            const f32x4 a0 = acc[0][nt], a1 = acc[1][nt];
            const unsigned ax = pk2n(bflo(gz.x) * (a0[0] + bias), bfhi(gz.x) * (a0[1] + bias)), ay = pk2n(bflo(gz.y) * (a0[2] + bias), bfhi(gz.y) * (a0[3] + bias));
            const unsigned bx = pk2n(bflo(gz.z) * (a1[0] + bias), bfhi(gz.z) * (a1[1] + bias)), by = pk2n(bflo(gz.w) * (a1[2] + bias), bfhi(gz.w) * (a1[3] + bias));
            auto s0 = __builtin_amdgcn_permlane16_swap(ax, bx, false, false); auto s1 = __builtin_amdgcn_permlane16_swap(ay, by, false, false);
            *(u32x4*)(YD + (size_t)(nb * 128 + t) * DI + g * 256 + wave * 32 + foff) = (u32x4){s0[0], s1[0], s0[1], s1[1]};
        }
        __syncthreads();
    }
}

constexpr float ATT_STOP = -152.0f;
template <bool DIAG>
__device__ __forceinline__ float sb_local(const f32x16& S, int l31, int hh, float (&att)[16]) {
    float run = 1.0f;
#pragma unroll
    for (int r = 15; r >= 0; --r) {
        float om = frcp(1.0f + fexp2(S[r]));
        if (DIAG) om = (16 * hh + r >= l31) ? 1.0f : om;
        const float rn = run * om;
        att[r] = run - rn; run = rn;
    }
    return run;
}
__device__ __forceinline__ void sb_scale(const float (&att)[16], float run, int hh, float& carry, bf16x8& p0, bf16x8& p1) {
    const float tot_o = __shfl_xor(run, 32);
    const float cf = fexp2(carry) * (hh == 0 ? tot_o : 1.0f);
    carry += __builtin_amdgcn_logf(run) + __builtin_amdgcn_logf(tot_o);
    u32x4 w0, w1;
    w0.x = pk2(att[0] * cf, att[1] * cf); w0.y = pk2(att[2] * cf, att[3] * cf); w0.z = pk2(att[4] * cf, att[5] * cf); w0.w = pk2(att[6] * cf, att[7] * cf);
    w1.x = pk2(att[8] * cf, att[9] * cf); w1.y = pk2(att[10] * cf, att[11] * cf); w1.z = pk2(att[12] * cf, att[13] * cf); w1.w = pk2(att[14] * cf, att[15] * cf);
    p0 = __builtin_bit_cast(bf16x8, w0); p1 = __builtin_bit_cast(bf16x8, w1);
}
constexpr int B2_SLOT = 16384, B2_NSLOT = 9, B2_FL = B2_SLOT * B2_NSLOT;
__device__ __forceinline__ void phaseB2(const Ptrs& P, LAS unsigned char* lds, int G, int dummy) {
    const int tid = opaque_tid(), lane = tid & 63, wave = __builtin_amdgcn_readfirstlane(tid >> 6), l31 = lane & 31, hh = lane >> 5;
    LAS int* FL = (LAS int*)(lds + B2_FL);
    const unsigned kb0 = l31 * 256 + ((hh ^ (l31 & 15)) << 4), vb0 = 8192 + l31 * 64 + ((((hh << 1) ^ (l31 >> 2)) & 3) << 4);
    unsigned gk, gv;
    {   const int irow = 4 * wave + (lane >> 4), key = 16 * ((irow >> 2) & 1) + 4 * (irow >> 3) + (irow & 3);
        gk = (unsigned)(key * DI + 8 * ((lane & 15) ^ (irow & 15)));
        const int d = 16 * wave + (lane >> 2);
        gv = (unsigned)(d * MT + 8 * ((lane & 3) ^ ((d >> 2) & 3))); }
    const bf16_t* Kg = (const bf16_t*)(P.ws + WS_R0); const bf16_t* VT = (const bf16_t*)(P.ws + WS_R1); bf16_t* QO = (bf16_t*)(P.ws + WS_R2); const bf16_t* SZ = (const bf16_t*)P.out;
    int res_lo = 1 << 30, res_hi = -1;
    for (int i = 0; i < 4; ++i) {
        const int c = blockIdx.x, bh = c & 63, jq = c >> 6; const int qb = 4 * jq + 3 - i;
        const int b = bh >> 4, h = bh & 15, q0 = qb * 256, tq0 = q0 + 32 * wave;
        const size_t tokbase = (size_t)b * SEQ;
        const bf16_t* kgb = Kg + tokbase * DI + h * DH;
        const bf16_t* vgb = VT + (size_t)(h * DH) * MT + tokbase;
#define B2_DMA(blk, slot) do { __builtin_amdgcn_global_load_lds((const unsigned*)(kgb + (size_t)(32 * (blk)) * DI + gk), (LAS unsigned*)(lds + (slot) * B2_SLOT + wave * 1024), 16, 0, 0); \
            __builtin_amdgcn_global_load_lds((const unsigned*)(vgb + 32 * (blk) + gv), (LAS unsigned*)(lds + (slot) * B2_SLOT + 8192 + wave * 1024), 16, 0, 0); } while (0)
        const int b0 = q0 >> 5;
        {   int sl = b0 % B2_NSLOT; bool any = false;
#pragma unroll
            for (int bi = 0; bi < 8; ++bi) { const int B = b0 + bi; if (B < res_lo || B > res_hi) { B2_DMA(B, sl); any = true; } sl = (sl == B2_NSLOT - 1) ? 0 : sl + 1; }
            if (any) { res_lo = b0; res_hi = b0 + 7; }
        }
        bf16x8 qf[8];
        { const bf16_t* qp = QO + (tokbase + tq0 + l31) * DI + h * DH + 8 * hh;
#pragma unroll
          for (int kk = 0; kk < 8; ++kk) qf[kk] = *(const bf16x8*)(qp + 16 * kk); }
        u32x4 gz[8];
        { const bf16_t* srow0 = SZ + (tokbase + tq0 + l31) * DI + h * DH + 8 * hh;
#pragma unroll
          for (int p = 0; p < 8; ++p) gz[p] = *(const u32x4*)(srow0 + 16 * p); }
        f32x16 O[4];
#pragma unroll
        for (int d = 0; d < 4; ++d)
#pragma unroll
            for (int r = 0; r < 16; ++r) O[d][r] = 0.f;
        float carry = 0.f; bool wdone = false;
        if (lane == 0) { FL[wave] = 0; FL[8 + wave] = 0; }
        int blk = b0 + wave, slot = blk % B2_NSLOT;
        int nblk = b0 - 1, nslot = (b0 + B2_NSLOT - 1) % B2_NSLOT, par = 0;
        asm volatile("s_waitcnt vmcnt(0)" ::: "memory");
        for (;;) {
            __syncthreads();
            if (dummy == 2) break;
            int nd = 0;
#pragma unroll
            for (int w = 0; w < 8; ++w) nd += FL[par * 8 + w];
            if (nd == 8) break;
            if (nblk >= 0 && nblk < res_lo) { B2_DMA(nblk, nslot); res_lo = nblk; res_hi = res_hi < nblk + 8 ? res_hi : nblk + 8; }
            if (!wdone) {
                LAS unsigned char* SB = lds + slot * B2_SLOT;
                f32x16 S;
#pragma unroll
                for (int r = 0; r < 16; ++r) S[r] = 0.f;
#pragma unroll
                for (int kk = 0; kk < 8; ++kk) {
                    const bf16x8 kf = *(const LAS bf16x8*)(SB + (kb0 ^ (kk << 5)));
                    S = __builtin_amdgcn_mfma_f32_32x32x16_bf16(kf, qf[kk], S, 0, 0, 0);
                }
                float att[16]; float run; bf16x8 p0, p1;
                if (32 * blk == tq0) run = sb_local<true>(S, l31, hh, att); else run = sb_local<false>(S, l31, hh, att);
                sb_scale(att, run, hh, carry, p0, p1);
#pragma unroll
                for (int db = 0; db < 4; ++db) {
                    const bf16x8 v0 = *(const LAS bf16x8*)(SB + db * 2048 + (vb0 ^ 0));
                    const bf16x8 v1 = *(const LAS bf16x8*)(SB + db * 2048 + (vb0 ^ 16));
                    O[db] = __builtin_amdgcn_mfma_f32_32x32x16_bf16(v0, p0, O[db], 0, 0, 0);
                    O[db] = __builtin_amdgcn_mfma_f32_32x32x16_bf16(v1, p1, O[db], 0, 0, 0);
                }
                wdone = (__ballot(carry < ATT_STOP) == ~0ull) || (blk == 0);
            }
            if (lane == 0) FL[(par ^ 1) * 8 + wave] = wdone ? 1 : 0;
            --blk; slot = (slot == 0) ? B2_NSLOT - 1 : slot - 1; --nblk; nslot = (nslot == 0) ? B2_NSLOT - 1 : nslot - 1; par ^= 1;
            asm volatile("s_waitcnt vmcnt(0)" ::: "memory");
        }
#undef B2_DMA
        if (!dummy || carry > 1e30f)
        { bf16_t* rowp = QO + (tokbase + tq0 + l31) * DI + h * DH + 8 * hh; const bf16_t* srow = SZ + (tokbase + tq0 + l31) * DI + h * DH + 8 * hh;
#pragma unroll
          for (int p = 0; p < 8; ++p) {
              auto r0 = __builtin_amdgcn_permlane32_swap(gz[p].x, gz[p].z, false, false); gz[p].x = r0[0]; gz[p].z = r0[1];
              auto r1 = __builtin_amdgcn_permlane32_swap(gz[p].y, gz[p].w, false, false); gz[p].y = r1[0]; gz[p].w = r1[1]; }
#pragma unroll
          for (int p = 0; p < 8; ++p) {
              const int db = p >> 1, a = 2 * (p & 1); const u32x4 g = gz[p];
              unsigned ax = pk2n(O[db][4 * a] * bflo(g.x), O[db][4 * a + 1] * bfhi(g.x)), ay = pk2n(O[db][4 * a + 2] * bflo(g.y), O[db][4 * a + 3] * bfhi(g.y));
              unsigned bx = pk2n(O[db][4 * a + 4] * bflo(g.z), O[db][4 * a + 5] * bfhi(g.z)), by = pk2n(O[db][4 * a + 6] * bflo(g.w), O[db][4 * a + 7] * bfhi(g.w));
              auto s0 = __builtin_amdgcn_permlane32_swap(ax, bx, false, false); auto s1 = __builtin_amdgcn_permlane32_swap(ay, by, false, false);
              *(u32x4*)(rowp + 16 * p) = (u32x4){s0[0], s1[0], s0[1], s1[1]};
          } }
        __syncthreads();
    }
}

__device__ __forceinline__ void phaseF(const Ptrs& P, int G) {
    const int tid = opaque_tid(), lane = tid & 63, wave = tid >> 6, gw = blockIdx.x * 8 + wave, NGW = G * 8;
    const bf16_t* XB = (const bf16_t*)(P.ws + WS_XB);
    for (int row = gw; row < MT; row += NGW) {
        const float rs = rstd_of(g_part, row);
        const u32x2* xr = (const u32x2*)(XB + (size_t)row * DM) + lane; f32x4* orow = (f32x4*)(P.out + (size_t)row * DM) + lane; const f32x4* gp = (const f32x4*)P.final_norm + lane;
#pragma unroll
        for (int j = 0; j < 4; ++j) { const u32x2 r = xr[64 * j]; const f32x4 gg = gp[64 * j]; orow[64 * j] = (f32x4){bflo(r.x), bfhi(r.x), bflo(r.y), bfhi(r.y)} * rs * gg; }
    }
}

#define XB_TMO      128
#define XB_XCNT(j)  (256  + 64 * (j))
#define XB_XSUB(j)  (1280 + 64 * (j))
#define XB_XGEN(j)  (2304 + 64 * (j))
#define XB_TOP      3328
#define XB_TOPGEN   3392
#define XCD_BAR_WORDS 3456
#define XB_SPIN_CAP (1u << 18)
__device__ unsigned g_bar[XCD_BAR_WORDS];
__device__ __forceinline__ unsigned xb_ld(unsigned* p)              { return __hip_atomic_load(p, __ATOMIC_RELAXED, __HIP_MEMORY_SCOPE_AGENT); }
__device__ __forceinline__ unsigned xb_add(unsigned* p, unsigned v) { return __hip_atomic_fetch_add(p, v, __ATOMIC_RELAXED, __HIP_MEMORY_SCOPE_AGENT); }
__device__ __forceinline__ unsigned xb_xcc_id() { return (unsigned)__builtin_amdgcn_s_getreg((3 << 11) | 20) & 0xFu; }
#define XB_SPIN(cond, bar) do { unsigned _sp = 0; while (cond) { __builtin_amdgcn_s_sleep(1); \
    if ((++_sp & 255u) == 0u) { if (xb_ld(&(bar)[XB_TMO])) break; if (_sp > XB_SPIN_CAP) { atomicAdd(&(bar)[XB_TMO], 1u); break; } } } } while (0)
struct XcdBarrier { unsigned* bar; unsigned x; volatile LAS unsigned* st; };
__device__ __forceinline__ XcdBarrier xcd_barrier_post(unsigned* bar, volatile LAS unsigned* st) {
    XcdBarrier b; b.bar = bar; b.x = xb_xcc_id(); b.st = st;
    if (threadIdx.x == 0) (void)xb_add(&bar[XB_XCNT(b.x)], 1u);
    return b;
}
__device__ __forceinline__ void xcd_barrier_complete(unsigned* bar, unsigned x, unsigned& nloc, unsigned& nx) {
    const unsigned G = gridDim.x * gridDim.y * gridDim.z;
    unsigned sum, cnt, mine, sp = 0u;
    for (;;) {
        sum = 0u; cnt = 0u; mine = 0u;
#pragma unroll
        for (unsigned j = 0; j < 16; ++j) { const unsigned c = xb_ld(&bar[XB_XCNT(j)]); sum += c; cnt += (c > 0u) ? 1u : 0u; mine = (j == x) ? c : mine; }
        if (sum == G) break;
        __builtin_amdgcn_s_sleep(1);
        if ((++sp & 255u) == 0u) { if (xb_ld(&bar[XB_TMO])) break; if (sp > XB_SPIN_CAP) { atomicAdd(&bar[XB_TMO], 1u); break; } }
    }
    nloc = mine > 0u ? mine : 1u; nx = cnt > 0u ? cnt : 1u;
}
__device__ __forceinline__ void xcd_barrier_a() {
    asm volatile("s_waitcnt vmcnt(0)" ::: "memory");
    __syncthreads();
}
template <bool DRAIN> __device__ __forceinline__ void xcd_barrier_b(const XcdBarrier& b);
__device__ __forceinline__ void xcd_barrier(const XcdBarrier& b) { xcd_barrier_a(); xcd_barrier_b<true>(b); }
template <bool DRAIN> __device__ __forceinline__ void xcd_barrier_b(const XcdBarrier& b) {
    if (threadIdx.x == 0) {
        unsigned* bar = b.bar;
        if (DRAIN) __builtin_amdgcn_s_waitcnt(0);
        unsigned nloc = b.st[0], nx = b.st[1];
        if (nloc == 0u) { xcd_barrier_complete(bar, b.x, nloc, nx); b.st[0] = nloc; b.st[1] = nx; }
        const unsigned old = xb_add(&bar[XB_XSUB(b.x)], 1u);
        const unsigned gen = old / nloc;
        if (old + 1u == (gen + 1u) * nloc) {
            __builtin_amdgcn_fence(__ATOMIC_RELEASE, "agent");
            asm volatile("s_waitcnt vmcnt(0)" ::: "memory");
            const unsigned og = xb_add(&bar[XB_TOP], 1u);
            const unsigned tg = og / nx;
            if (og + 1u == (tg + 1u) * nx) xb_add(&bar[XB_TOPGEN], 1u);
            else XB_SPIN(xb_ld(&bar[XB_TOPGEN]) == tg, bar);
            __builtin_amdgcn_fence(__ATOMIC_ACQUIRE, "agent");
            xb_add(&bar[XB_XGEN(b.x)], 1u);
            asm volatile("s_waitcnt vmcnt(0)" ::: "memory");
        } else {
            XB_SPIN(xb_ld(&bar[XB_XGEN(b.x)]) == gen, bar);
            __builtin_amdgcn_fence(__ATOMIC_ACQUIRE, "agent");
            asm volatile("s_waitcnt vmcnt(0)" ::: "memory");
        }
    }
    __syncthreads();
}

constexpr int LDS_BYTES = 152 * 1024;
__global__ void __launch_bounds__(512) yoco_fwd(Ptrs P) {
    extern __shared__ __attribute__((aligned(16))) unsigned char lds_raw[];
    LAS unsigned char* lds = (LAS unsigned char*)lds_raw;
    cg::grid_group grid = cg::this_grid();
    const int G = gridDim.x, c = blockIdx.x;
    unsigned char* ws = P.ws;
    bf16_t* R0 = (bf16_t*)(ws + WS_R0); bf16_t* R1 = (bf16_t*)(ws + WS_R1); bf16_t* R2 = (bf16_t*)(ws + WS_R2); bf16_t* XB = (bf16_t*)(ws + WS_XB);
    const bf16_t* WA = (const bf16_t*)(ws + WS_R2); const bf16_t* WB = (const bf16_t*)(ws + WS_WB);

    volatile LAS unsigned* xst = (volatile LAS unsigned*)(lds + LDS_BYTES - 16);
    if (threadIdx.x < 4) xst[threadIdx.x] = 0u;
    if (blockIdx.x == 0) { for (int i = threadIdx.x; i < XCD_BAR_WORDS; i += 512) g_bar[i] = 0u; for (int i = threadIdx.x; i < 64 * 16; i += 512) g_cnt[i] = 0u; }
    __syncthreads();
    const XcdBarrier xb1 = xcd_barrier_post((unsigned*)P.out, xst);
    if (P.ws == nullptr) grid.sync();
    phase0(P, lds, G);
    if (REP_P0) { __syncthreads(); phase0(P, lds, G); }
    GSYNC(xb1);
    const XcdBarrier xb2 = xcd_barrier_post(g_bar, xst + 2);

    for (int layer = 0; layer < 2; ++layer) {
        const bf16_t* W = WA + layer * WA_LAYER;
        for (int rep = 0; rep < 1 + REP_A1; ++rep) {
        {
            pg8::Gemm g{XB, W + WA_UZ, MT, 4096, DM}; pg8::StaticOrder S; S.init(MT, 4096, G, c);
            EpiUZ E{R0, g_part};
            pg8::gemm_phase<EpiUZ, pg8::StaticOrder, true, true>(lds, g, S, E);
        }
        {
            pg8::Gemm g{W + WA_V, XB, DI, MT, DM}; pg8::StaticOrder S; S.init(DI, MT, G, c);
            EpiT<1> E{R1, g_part, g_lnpart};
            pg8::gemm_phase<EpiT<1>, pg8::StaticOrder, true, true>(lds, g, S, E);
        }
        }
        GSYNC(xb1);
        phaseA2(P, layer, lds, G, R0);
        {
            pg8::Gemm g{R0, W + WA_OUT, MT, DM, DI}; pg8::StaticOrder S; S.init(MT, DM, G, c);
            EpiOut E{nullptr, XB, g_part, nullptr, nullptr, nullptr};
            f32x4 pre[2][2][4][2];
            xcd_barrier_a();
            { pg8::Unit u0; const int t_ = opaque_tid(), w_ = t_ >> 6, l_ = t_ & 63; S.next(0, u0); E.init(pre, u0, w_ >> 2, w_ & 3, l_ & 15, l_ >> 4); }
            xcd_barrier_b<false>(xb1);
            pg8::gemm_phase_pre<EpiOut, pg8::StaticOrder, false, true>(lds, g, S, E, pre);
        }
        if (layer == 0) GSYNC(xb1); else GSYNC(xb2);
    }
    for (int layer = 0; layer < 2; ++layer) {
        for (int rep = 0; rep < 1 + (layer == 0 ? REP_B1 : 0); ++rep) {
        {
            const int N = layer == 0 ? 6144 : 4096;
            pg8::Gemm g{XB, WB + (layer == 0 ? WB_K : WB_Q1), MT, N, DM}; pg8::StaticOrder S; S.init(MT, N, G, c);
            const long long dq = (long long)((char*)R2 - (char*)R0), dz0 = (long long)((char*)P.out - (char*)R0), dz1 = (long long)((char*)P.out - (char*)R2);
            EpiRS E{layer == 0 ? R0 : R2, layer == 0 ? dq : dz1, layer == 0 ? dz0 : 0ll, QSCALE, layer == 0 ? 1 : 0, layer == 0 ? 2 : 1, g_part};
            pg8::gemm_phase<EpiRS, pg8::StaticOrder, true, true>(lds, g, S, E);
        }
        if (layer == 0) {
            pg8::Gemm g{WB + WB_VV, XB, DI, MT, DM}; pg8::StaticOrder S; S.init(DI, MT, G, c);
            EpiT<0> E{R1, g_part, nullptr};
            pg8::gemm_phase<EpiT<0>, pg8::StaticOrder, true, true>(lds, g, S, E);
        }
        }
        GSYNC(xb2);
        if (REP_B2) phaseB2(P, lds, G, REP_B2);
        phaseB2(P, lds, G, 0);
        {
            pg8::Gemm g{R2, WB + (layer ? WB_OUT1 : WB_OUT0), MT, DM, DI}; pg8::StaticOrder S; S.init(MT, DM, G, c);
            EpiOut E{nullptr, XB, g_part, layer == 1 ? P.out : nullptr, P.final_norm, g_cnt};
            f32x4 pre[2][2][4][2];
            xcd_barrier_a();
            { pg8::Unit u0; const int t_ = opaque_tid(), w_ = t_ >> 6, l_ = t_ & 63; S.next(0, u0); E.init(pre, u0, w_ >> 2, w_ & 3, l_ & 15, l_ >> 4); }
            xcd_barrier_b<false>(xb2);
            pg8::gemm_phase_pre<EpiOut, pg8::StaticOrder, false, true>(lds, g, S, E, pre);
        }
        if (layer == 0) GSYNC(xb2);
    }
}

extern "C" void kernel_launch(void* const* d_in, const int* in_sizes, int n_in, void* d_out, int out_size, void* d_ws, size_t ws_size, hipStream_t stream) {
    static int grid = 0;
    if (grid == 0) {
        if (n_in != 14 || out_size != MT * DM || ws_size < 256 * MiB) { fprintf(stderr, "kernel_launch: unexpected shapes (n_in %d out %d ws %zu)\n", n_in, out_size, ws_size); grid = -1; return; }
        int dev = 0, cus = 0, per_cu = 0;
        hipGetDevice(&dev); hipDeviceGetAttribute(&cus, hipDeviceAttributeMultiprocessorCount, dev);
        if (hipFuncSetAttribute((const void*)yoco_fwd, hipFuncAttributeMaxDynamicSharedMemorySize, LDS_BYTES) != hipSuccess) { fprintf(stderr, "kernel_launch: hipFuncSetAttribute failed\n"); grid = -1; return; }
        hipOccupancyMaxActiveBlocksPerMultiprocessor(&per_cu, (const void*)yoco_fwd, 512, LDS_BYTES);
        (void)hipGetLastError();
        grid = cus * (per_cu > 0 ? per_cu : 1);
        if (grid > 256) grid = 256;
        fprintf(stderr, "kernel_launch: cus %d per_cu %d grid %d ws %zu\n", cus, per_cu, grid, ws_size);
        if (grid != 256) { fprintf(stderr, "kernel_launch: needs 256 co-resident workgroups\n"); grid = -1; return; }
    }
    if (grid < 0) return;
    if (hipMemsetAsync(d_out, 0, XCD_BAR_WORDS * sizeof(unsigned), stream) != hipSuccess) { fprintf(stderr, "kernel_launch: memset failed\n"); return; }
    Ptrs p{};
    p.x = (const float*)d_in[0]; p.a_norm = (const float*)d_in[1]; p.a_w_in = (const float*)d_in[2]; p.a_ln_g = (const float*)d_in[3]; p.a_ln_b = (const float*)d_in[4];
    p.a_w_s = (const float*)d_in[5]; p.a_b_s = (const float*)d_in[6]; p.a_w_out = (const float*)d_in[7]; p.kv_norm = (const float*)d_in[8]; p.w_kv = (const float*)d_in[9];
    p.b_norm = (const float*)d_in[10]; p.b_w_in = (const float*)d_in[11]; p.b_w_out = (const float*)d_in[12]; p.final_norm = (const float*)d_in[13];
    p.out = (float*)d_out; p.ws = (unsigned char*)d_ws;
    void* args[] = {&p};
    hipError_t e = hipLaunchCooperativeKernel((const void*)yoco_fwd, dim3(grid), dim3(512), args, LDS_BYTES, stream);
    if (e != hipSuccess) fprintf(stderr, "kernel_launch: cooperative launch failed: %s\n", hipGetErrorString(e));
}
```

```cpp
#include <hip/hip_runtime.h>
#include <hip/hip_cooperative_groups.h>
#include <cstdio>
#include <cstdint>
namespace cg = cooperative_groups;
#define REP_SYNC 0
#define REP_P0 0
#define REP_A1 0
#define REP_A2 0
#define REP_B2 0
#define REP_B1 0
#define REP_A3 0
#define GSYNC(xb) do { xcd_barrier(xb); for (int r_ = 0; r_ < REP_SYNC; ++r_) xcd_barrier(xb); } while (0)

#define LAS __attribute__((address_space(3)))
typedef unsigned short bf16_t;
typedef short bf16x8 __attribute__((ext_vector_type(8)));
typedef float f32x4 __attribute__((ext_vector_type(4)));
typedef float f32x16 __attribute__((ext_vector_type(16)));
typedef float f32x2 __attribute__((ext_vector_type(2)));
typedef unsigned u32x4 __attribute__((ext_vector_type(4)));
typedef unsigned u32x2 __attribute__((ext_vector_type(2)));

constexpr int DM = 1024, NB = 4, SEQ = 4096, MT = NB * SEQ  , DI = 2048, NH = 16, DH = 128;
constexpr float EPS = 1e-6f;
constexpr float LOG2E = 1.4426950408889634f;
constexpr float QSCALE = 0.08838834764831845f * LOG2E;
constexpr float GELU_K = 2.0f * 0.7978845608028654f * LOG2E;

constexpr size_t MiB = 1024ull * 1024ull;
constexpr size_t WS_R0 = 0, WS_R1 = 64 * MiB, WS_R2 = 128 * MiB, WS_XB = 192 * MiB, WS_WB = 224 * MiB;
constexpr size_t Mi = 1024ull * 1024ull;
constexpr size_t WA_LAYER = 8 * Mi, WA_UZ = 0, WA_V = 4 * Mi, WA_OUT = 6 * Mi;
constexpr size_t WB_K = 0, WB_Q0 = 2 * Mi, WB_Z0 = 4 * Mi, WB_VV = 6 * Mi, WB_Q1 = 8 * Mi, WB_Z1 = 10 * Mi, WB_OUT0 = 12 * Mi, WB_OUT1 = 14 * Mi;

__device__ float g_part[MT * 4];
__device__ float g_lnpart[MT * 32];
__device__ bf16_t g_wsm[2 * 8 * 128 * 128];
__device__ unsigned g_cnt[64 * 16];

__device__ __forceinline__ unsigned pk2(float lo, float hi) { unsigned r; asm volatile("v_cvt_pk_bf16_f32 %0, %1, %2" : "=v"(r) : "v"(lo), "v"(hi)); return r; }
__device__ __forceinline__ void store16_wt(void* p, u32x4 v) { asm volatile("global_store_dwordx4 %0, %1, off sc1\n\ts_nop 1" :: "v"(p), "v"(v) : "memory"); }
__device__ __forceinline__ unsigned pk2n(float lo, float hi) { unsigned r; asm volatile("v_cvt_pk_bf16_f32 %0, %1, %2\n\ts_nop 1" : "=v"(r) : "v"(lo), "v"(hi)); return r; }
__device__ __forceinline__ u32x4 lane_regroup(u32x4 w, int baddr) {
    u32x4 t; t.x = __builtin_amdgcn_ds_bpermute(baddr, w.x); t.y = __builtin_amdgcn_ds_bpermute(baddr, w.y); t.z = __builtin_amdgcn_ds_bpermute(baddr, w.z); t.w = __builtin_amdgcn_ds_bpermute(baddr, w.w); return t;
}
__device__ __forceinline__ float bflo(unsigned w) { return __uint_as_float(w << 16); }
__device__ __forceinline__ float bfhi(unsigned w) { return __uint_as_float(w & 0xffff0000u); }
__device__ __forceinline__ float fexp2(float x) { return __builtin_amdgcn_exp2f(x); }
__device__ __forceinline__ float frcp(float x) { return __builtin_amdgcn_rcpf(x); }
__device__ __forceinline__ float gelu_tanh(float x) { const float t = x * (1.0f + 0.044715f * x * x); return x * frcp(1.0f + fexp2(-GELU_K * t)); }
__device__ __forceinline__ float silu(float z) { return z * frcp(1.0f + fexp2(-LOG2E * z)); }
__device__ __forceinline__ float rstd_of(const float* part, int row) { const f32x4 p = *(const f32x4*)(part + (size_t)row * 4); return rsqrtf(((p[0] + p[1]) + (p[2] + p[3])) * (1.0f / DM) + EPS); }
__device__ __forceinline__ void load_rstd8(const float* part, int row0, float sc, float (&rsv)[8]) {
    f32x4 p[8];
#pragma unroll
    for (int e = 0; e < 8; ++e) p[e] = *(const f32x4*)(part + (size_t)(row0 + (e >> 2) * 128 + (e & 3) * 16) * 4);
    asm volatile("" : "+v"(p[0]), "+v"(p[1]), "+v"(p[2]), "+v"(p[3]), "+v"(p[4]), "+v"(p[5]), "+v"(p[6]), "+v"(p[7]));
#pragma unroll
    for (int e = 0; e < 8; ++e) rsv[e] = rsqrtf(((p[e][0] + p[e][1]) + (p[e][2] + p[e][3])) * (1.0f / DM) + EPS) * sc;
}
__device__ __forceinline__ float wave_sum(float v) {
#pragma unroll
    for (int o = 1; o < 64; o <<= 1) v += __shfl_xor(v, o);
    return v;
}

__device__ __forceinline__ int opaque_tid() { int t = threadIdx.x; asm volatile("" : "+v"(t)); return t; }
namespace pg8 {
#define PG8_LAS __attribute__((address_space(3)))
constexpr int BM = 256, BK = 64, HALF = 128, HTB = HALF * BK * 2, STAGE_BYTES = 8 * HTB, NXCD = 8, WGM = 8;
__host__ __device__ __forceinline__ int lds_byte(int r, int c) { const int st = (r >> 4) * 2 + (c >> 5), rr = r & 15, cc = c & 31, ob = rr * 64 + cc * 2; return st * 1024 + (ob ^ (((ob >> 9) & 1) << 5)); }
__host__ __device__ __forceinline__ void stage_rc(int b, int& R, int& C) { const int st = b / 1024, sb = b % 1024, swz = sb ^ (((sb >> 9) & 1) << 5); R = (st >> 1) * 16 + swz / 64; C = (st & 1) * 32 + (swz % 64) / 2; }
__host__ __device__ __forceinline__ int perm32(int rho) { const int n = rho >> 4, i = rho & 15; return 8 * (i >> 2) + 4 * n + (i & 3); }
struct Unit { int pm, pn; };
struct Gemm { const bf16_t* A; const bf16_t* Bt; int M, N, K; };
struct StaticOrder {
    int nM, nN, nwg, G, c;
    __host__ __device__ void init(int M, int N, int G_, int c_) { nM = M / BM; nN = N / BM; nwg = nM * nN; G = G_; c = c_; }
    __host__ __device__ bool next(int i, Unit& u) const {
        const long L = (long)i * G + c; if (L >= nwg) return false;
        int wgid = (int)L; { const int q = nwg / NXCD, r = nwg % NXCD, xcd = wgid % NXCD, off = wgid / NXCD; wgid = (xcd < r ? xcd * (q + 1) : r * (q + 1) + (xcd - r) * q) + off; }
        const int nig = WGM * nN, gid = wgid / nig, fm = gid * WGM, gsz = (nM - fm) < WGM ? (nM - fm) : WGM;
        u.pm = fm + ((wgid % nig) % gsz); u.pn = (wgid % nig) / gsz; return true;
    }
    __device__ __forceinline__ void a_ready(const Unit&) const {}
    __device__ __forceinline__ void done(const Unit&) const {}
};
template <class Epi, class Sched, bool ALIGN_EPI, bool SP2, bool PRE>
__device__ __forceinline__ void gemm_phase_impl(PG8_LAS unsigned char* lds, const Gemm g, const Sched& S, const Epi& E, const f32x4 (&pre)[2][2][4][2]) {
    const int tid = opaque_tid(), wid = __builtin_amdgcn_readfirstlane(tid >> 6), lane = tid & 63, wr = wid >> 2, wc = wid & 3, fr = lane & 15, fq = lane >> 4;
    const int K = g.K, nt = K / BK;
    unsigned voffA[2], voffB[2];
#pragma unroll
    for (int i = 0; i < 2; ++i) { int R, C; stage_rc(tid * 16 + i * 8192, R, C); const int Rb = Epi::PERM ? ((R & ~31) + perm32(R & 31)) : R;
        voffA[i] = (unsigned)(R * K + C) * 2u; voffB[i] = (unsigned)(Rb * K + C) * 2u; }
    const size_t kstep = (size_t)(BK * 2);
    const size_t hstep = (size_t)HALF * K * 2;
    const size_t tstep = 2 * hstep;
    const unsigned ldsw = (unsigned)wid * 1024u;
    const int aoff = lds_byte(wr * 64 + fr, fq * 8), boff = lds_byte(wc * 32 + fr, fq * 8);
#define PG8_SA(b, h) (((b) * 2 + (h)) * HTB)
#define PG8_SB(b, h) ((4 + (b) * 2 + (h)) * HTB)
#define PG8_STAGE(bufoff, gbase, voff) do { _Pragma("unroll") for (int _i = 0; _i < 2; ++_i) \
        __builtin_amdgcn_global_load_lds((const unsigned*)((const char*)(gbase) + (voff)[_i]), (PG8_LAS unsigned*)(lds + (bufoff) + ldsw + _i * 8192), 16, 0, 0); } while (0)
#define PG8_LDA(dst, b, h) do { _Pragma("unroll") for (int m = 0; m < 4; ++m) _Pragma("unroll") for (int k = 0; k < 2; ++k) dst[m][k] = *(const PG8_LAS bf16x8*)(lds + PG8_SA(b, h) + aoff + m * 2048 + k * 1024); } while (0)
#define PG8_LDB(dst, b, h) do { _Pragma("unroll") for (int n = 0; n < 2; ++n) _Pragma("unroll") for (int k = 0; k < 2; ++k) dst[n][k] = *(const PG8_LAS bf16x8*)(lds + PG8_SB(b, h) + boff + n * 2048 + k * 1024); } while (0)
#define PG8_MMA(ai, bj, At, Bt) do { __builtin_amdgcn_s_setprio(1); _Pragma("unroll") for (int m = 0; m < 4; ++m) _Pragma("unroll") for (int n = 0; n < 2; ++n) _Pragma("unroll") for (int k = 0; k < 2; ++k) \
        acc[ai][bj][m][n] = __builtin_amdgcn_mfma_f32_16x16x32_bf16(Bt[n][k], At[m][k], acc[ai][bj][m][n], 0, 0, 0); __builtin_amdgcn_s_setprio(0); } while (0)
#define PG8_WAIT_V(n) asm volatile("s_waitcnt vmcnt(" #n ")" ::: "memory")
#define PG8_WAIT_L(n) asm volatile("s_waitcnt lgkmcnt(" #n ")" ::: "memory")
#define PG8_BAR __builtin_amdgcn_s_barrier()
#define PG8_SCHED __builtin_amdgcn_sched_barrier(0)
    Unit cur, nxt; int ui = 0;
    if (!S.next(0, cur)) return;
    f32x4 acc[2][2][4][2];
    if constexpr (Epi::INIT) {
        if constexpr (PRE) {
#pragma unroll
            for (int a = 0; a < 2; ++a)
#pragma unroll
                for (int b = 0; b < 2; ++b)
#pragma unroll
                    for (int m = 0; m < 4; ++m)
#pragma unroll
                        for (int n = 0; n < 2; ++n) acc[a][b][m][n] = pre[a][b][m][n];
        } else E.init(acc, cur, wr, wc, fr, fq);
    }
    else {
#pragma unroll
    for (int a = 0; a < 2; ++a)
#pragma unroll
        for (int b = 0; b < 2; ++b)
#pragma unroll
            for (int m = 0; m < 4; ++m)
#pragma unroll
                for (int n = 0; n < 2; ++n) acc[a][b][m][n] = (f32x4){0.f, 0.f, 0.f, 0.f};
    }
    bf16x8 At[4][2], B0[2][2], B1[2][2];
    const char* cA = (const char*)g.A + (size_t)cur.pm * tstep; const char* cB = (const char*)g.Bt + (size_t)cur.pn * tstep;
    S.a_ready(cur);
    if constexpr (SP2) {
        PG8_STAGE(PG8_SB(0, 0), cB, voffB); PG8_STAGE(PG8_SB(0, 1), cB + hstep, voffB); PG8_STAGE(PG8_SA(0, 0), cA, voffA); PG8_STAGE(PG8_SA(0, 1), cA + hstep, voffA);
        if (wr == 1) PG8_BAR;
        PG8_WAIT_V(2); PG8_BAR;
        PG8_STAGE(PG8_SB(1, 0), cB + kstep, voffB); PG8_STAGE(PG8_SA(1, 0), cA + kstep, voffA); PG8_STAGE(PG8_SB(1, 1), cB + hstep + kstep, voffB);
        PG8_WAIT_V(6); PG8_BAR;
    } else {
        PG8_STAGE(PG8_SB(0, 0), cB, voffB); PG8_STAGE(PG8_SA(0, 0), cA, voffA); PG8_STAGE(PG8_SB(0, 1), cB + hstep, voffB); PG8_STAGE(PG8_SA(0, 1), cA + hstep, voffA);
        if (wr == 1) PG8_BAR;
        PG8_WAIT_V(4); PG8_BAR;
        PG8_STAGE(PG8_SB(1, 0), cB + kstep, voffB); PG8_STAGE(PG8_SA(1, 0), cA + kstep, voffA); PG8_STAGE(PG8_SB(1, 1), cB + hstep + kstep, voffB);
        PG8_WAIT_V(6); PG8_BAR;
    }
    for (;;) {
        const bool has_next = S.next(ui + 1, nxt);
        const char* nA = has_next ? (const char*)g.A + (size_t)nxt.pm * tstep : cA; const char* nB = has_next ? (const char*)g.Bt + (size_t)nxt.pn * tstep : cB;
        for (int t = 0; t < nt; t += 2) {
            const bool last = (t == nt - 2);
            const char* a1 = cA + (size_t)(t + 1) * kstep;
            const char* a2 = last ? nA : cA + (size_t)(t + 2) * kstep; const char* b2 = last ? nB : cB + (size_t)(t + 2) * kstep;
            const char* a3 = a2 + kstep; const char* b3 = b2 + kstep;
            if (last && has_next) S.a_ready(nxt);
            if constexpr (SP2) {
            PG8_LDB(B0, 0, 0); PG8_LDB(B1, 0, 1); PG8_SCHED; PG8_LDA(At, 0, 0); PG8_STAGE(PG8_SA(1, 1), a1 + hstep, voffA);
            PG8_WAIT_V(8); PG8_WAIT_L(0); PG8_BAR; PG8_MMA(0, 0, At, B0); PG8_MMA(0, 1, At, B1); PG8_BAR; PG8_SCHED;
            PG8_LDA(At, 0, 1); PG8_STAGE(PG8_SB(0, 0), b2, voffB); PG8_STAGE(PG8_SB(0, 1), b2 + hstep, voffB); PG8_STAGE(PG8_SA(0, 0), a2, voffA);
            PG8_WAIT_V(8); PG8_WAIT_L(0); PG8_BAR; PG8_MMA(1, 0, At, B0); PG8_MMA(1, 1, At, B1); PG8_BAR; PG8_SCHED;
            PG8_LDB(B0, 1, 0); PG8_LDB(B1, 1, 1); PG8_SCHED; PG8_LDA(At, 1, 0); PG8_STAGE(PG8_SA(0, 1), a2 + hstep, voffA);
            PG8_WAIT_V(8); PG8_WAIT_L(0); PG8_BAR; PG8_MMA(0, 0, At, B0); PG8_MMA(0, 1, At, B1); PG8_BAR; PG8_SCHED;
            PG8_LDA(At, 1, 1); PG8_STAGE(PG8_SB(1, 0), b3, voffB); PG8_STAGE(PG8_SB(1, 1), b3 + hstep, voffB); PG8_STAGE(PG8_SA(1, 0), a3, voffA);
            PG8_WAIT_V(8); PG8_WAIT_L(0); PG8_BAR; PG8_MMA(1, 0, At, B0); PG8_MMA(1, 1, At, B1); PG8_BAR; PG8_SCHED;
            } else {
            PG8_LDB(B0, 0, 0); PG8_SCHED; PG8_LDA(At, 0, 0); PG8_STAGE(PG8_SA(1, 1), a1 + hstep, voffA);
            PG8_WAIT_L(8); PG8_BAR; PG8_WAIT_L(0); PG8_MMA(0, 0, At, B0); PG8_BAR; PG8_SCHED;
            PG8_LDB(B1, 0, 1); PG8_STAGE(PG8_SB(0, 0), b2, voffB);
            PG8_BAR; PG8_WAIT_L(0); PG8_MMA(0, 1, At, B1); PG8_BAR;
            PG8_LDA(At, 0, 1); PG8_STAGE(PG8_SA(0, 0), a2, voffA);
            PG8_BAR; PG8_WAIT_L(0); PG8_MMA(1, 0, At, B0); PG8_BAR; PG8_SCHED;
            PG8_STAGE(PG8_SB(0, 1), b2 + hstep, voffB);
            PG8_WAIT_V(6); PG8_BAR; PG8_MMA(1, 1, At, B1); PG8_BAR;
            PG8_LDB(B0, 1, 0); PG8_SCHED; PG8_LDA(At, 1, 0); PG8_STAGE(PG8_SA(0, 1), a2 + hstep, voffA);
            PG8_WAIT_L(8); PG8_BAR; PG8_WAIT_L(0); PG8_MMA(0, 0, At, B0); PG8_BAR; PG8_SCHED;
            PG8_LDB(B1, 1, 1); PG8_STAGE(PG8_SB(1, 0), b3, voffB);
            PG8_BAR; PG8_WAIT_L(0); PG8_MMA(0, 1, At, B1); PG8_BAR;
            PG8_LDA(At, 1, 1); PG8_STAGE(PG8_SA(1, 0), a3, voffA);
            PG8_BAR; PG8_WAIT_L(0); PG8_MMA(1, 0, At, B0); PG8_BAR; PG8_SCHED;
            PG8_STAGE(PG8_SB(1, 1), b3 + hstep, voffB);
            PG8_WAIT_V(6); PG8_BAR; PG8_MMA(1, 1, At, B1); PG8_BAR;
            }
        }
        if constexpr (ALIGN_EPI) { if (wr == 0) PG8_BAR; }
        if constexpr (!Epi::AFTER_DRAIN) { E(acc, cur, wr, wc, fr, fq); S.done(cur); }
        if (!has_next) break;
#pragma unroll
        for (int a = 0; a < 2; ++a)
#pragma unroll
            for (int b = 0; b < 2; ++b)
#pragma unroll
                for (int m = 0; m < 4; ++m)
#pragma unroll
                    for (int n = 0; n < 2; ++n) acc[a][b][m][n] = (f32x4){0.f, 0.f, 0.f, 0.f};
        cur = nxt; cA = nA; cB = nB; ++ui;
        if constexpr (ALIGN_EPI) { if (wr == 1) PG8_BAR; }
    }
    PG8_WAIT_V(0);
    if constexpr (!ALIGN_EPI) { if (wr == 0) PG8_BAR; }
    PG8_BAR;
    if constexpr (Epi::AFTER_DRAIN) { E.fused(acc, cur, wr, wc, fr, fq, lds, wid, lane); S.done(cur); }
#undef PG8_SA
#undef PG8_SB
#undef PG8_STAGE
#undef PG8_LDA
#undef PG8_LDB
#undef PG8_MMA
#undef PG8_WAIT_V
#undef PG8_WAIT_L
#undef PG8_BAR
#undef PG8_SCHED
}
template <class Epi, class Sched, bool ALIGN_EPI = false, bool SP2 = false>
__device__ __forceinline__ void gemm_phase(PG8_LAS unsigned char* lds, const Gemm g, const Sched& S, const Epi& E) { f32x4 none[2][2][4][2]; gemm_phase_impl<Epi, Sched, ALIGN_EPI, SP2, false>(lds, g, S, E, none); }
template <class Epi, class Sched, bool ALIGN_EPI = false, bool SP2 = false>
__device__ __forceinline__ void gemm_phase_pre(PG8_LAS unsigned char* lds, const Gemm g, const Sched& S, const Epi& E, const f32x4 (&pre)[2][2][4][2]) { gemm_phase_impl<Epi, Sched, ALIGN_EPI, SP2, true>(lds, g, S, E, pre); }
}

struct EpiUZ {
    static constexpr bool PERM = true, AFTER_DRAIN = false, INIT = false;
    bf16_t* GUZ; const float* part;
    __device__ __forceinline__ void operator()(const f32x4 (&acc)[2][2][4][2], const pg8::Unit& u, int wr, int wc, int fr, int fq) const {
        const int row0 = u.pm * 256 + wr * 64 + fr, col0 = u.pn * 128 + wc * 32 + 8 * fq;
        float rsv[8]; load_rstd8(part, row0, 1.0f, rsv);
        const int L_ = fr + 16 * fq, baddr = 4 * ((L_ >> 2) + 16 * (L_ & 3)), rowp0 = u.pm * 256 + wr * 64 + (L_ >> 2), colp0 = u.pn * 128 + wc * 32 + 8 * (L_ & 3);
#pragma unroll
        for (int ai = 0; ai < 2; ++ai)
#pragma unroll
            for (int m = 0; m < 4; ++m) {
                const int row = row0 + ai * 128 + m * 16; const float rs = rsv[ai * 4 + m];
                float o[8];
#pragma unroll
                for (int n = 0; n < 2; ++n) {
                    const f32x4 uu = acc[ai][0][m][n] * rs, zz = acc[ai][1][m][n] * rs;
                    const f32x4 ea = uu * (uu * uu * (-0.044715f * GELU_K) + (-GELU_K)), eb = acc[ai][1][m][n] * (rs * -LOG2E);
                    f32x4 xa, xb;
#pragma unroll
                    for (int j = 0; j < 4; ++j) { xa[j] = fexp2(ea[j]); xb[j] = fexp2(eb[j]); }
                    const f32x4 den = (xa + 1.0f) * (xb + 1.0f), num = uu * zz;
#pragma unroll
                    for (int j = 0; j < 4; ++j) o[n * 4 + j] = num[j] * frcp(den[j]);
                }
                u32x4 w; w.x = pk2(o[0], o[1]); w.y = pk2(o[2], o[3]); w.z = pk2(o[4], o[5]); w.w = pk2(o[6], o[7]);
                store16_wt(GUZ + (size_t)(rowp0 + ai * 128 + m * 16) * DI + colp0, lane_regroup(w, baddr));
            }
    }
};
template <int ACT> struct EpiT {
    static constexpr bool PERM = true, AFTER_DRAIN = false, INIT = false;
    bf16_t* OT; const float* part; float* lnpart;
    __device__ __forceinline__ void operator()(const f32x4 (&acc)[2][2][4][2], const pg8::Unit& u, int wr, int wc, int fr, int fq) const {
        const int frow0 = u.pm * 256 + wr * 64 + fr;
#pragma unroll
        for (int bj = 0; bj < 2; ++bj) {
            const int tok0 = u.pn * 256 + bj * 128 + wc * 32 + 8 * fq;
            const int L_ = fr + 16 * fq, baddr = 4 * ((L_ >> 2) + 16 * (L_ & 3)), frowp0 = u.pm * 256 + wr * 64 + (L_ >> 2), tokp0 = u.pn * 256 + bj * 128 + wc * 32 + 8 * (L_ & 3);
            float rs[8], s[8], q[8];
#pragma unroll
            for (int e = 0; e < 8; ++e) { rs[e] = rstd_of(part, tok0 + e); s[e] = 0.f; q[e] = 0.f; }
#pragma unroll
            for (int ai = 0; ai < 2; ++ai)
#pragma unroll
                for (int m = 0; m < 4; ++m) {
                    float o[8];
#pragma unroll
                    for (int n = 0; n < 2; ++n)
#pragma unroll
                        for (int j = 0; j < 4; ++j) { float v = acc[ai][bj][m][n][j] * rs[n * 4 + j]; if (ACT == 1) { v = gelu_tanh(v); s[n * 4 + j] += v; q[n * 4 + j] += v * v; } o[n * 4 + j] = v; }
                    u32x4 w; w.x = pk2(o[0], o[1]); w.y = pk2(o[2], o[3]); w.z = pk2(o[4], o[5]); w.w = pk2(o[6], o[7]);
                    store16_wt(OT + (size_t)(frowp0 + ai * 128 + m * 16) * MT + tokp0, lane_regroup(w, baddr));
                }
            if (ACT == 1) {
#pragma unroll
                for (int e = 0; e < 8; ++e) {
#pragma unroll
                    for (int o = 1; o < 16; o <<= 1) { s[e] += __shfl_xor(s[e], o); q[e] += __shfl_xor(q[e], o); }
                    if (fr == 0) *(f32x2*)(lnpart + (size_t)(tok0 + e) * 32 + (u.pm * 2 + wr) * 2) = (f32x2){s[e], q[e]};
                }
            }
        }
    }
};
struct EpiRS {
    static constexpr bool PERM = true, AFTER_DRAIN = false, INIT = false;
    bf16_t* O0; long long d1, d2; float qs; int qreg, zreg; const float* part;
    __device__ __forceinline__ void operator()(const f32x4 (&acc)[2][2][4][2], const pg8::Unit& u, int wr, int wc, int fr, int fq) const {
        const int reg = u.pn >> 3; bf16_t* O = (bf16_t*)((char*)O0 + (reg == 1 ? d1 : 0ll) + (reg == 2 ? d2 : 0ll)); const float sc = (reg == qreg) ? qs : 1.0f; const bool act = (reg == zreg);
        const int row0 = u.pm * 256 + wr * 64 + fr, col0 = (u.pn & 7) * 256 + wc * 32 + 8 * fq;
        float rsv[8]; load_rstd8(part, row0, sc, rsv);
        const int L_ = fr + 16 * fq, baddr = 4 * ((L_ >> 2) + 16 * (L_ & 3)), rowp0 = u.pm * 256 + wr * 64 + (L_ >> 2), colp0 = (u.pn & 7) * 256 + wc * 32 + 8 * (L_ & 3);
#pragma unroll
        for (int ai = 0; ai < 2; ++ai)
#pragma unroll
            for (int m = 0; m < 4; ++m) {
                const int row = row0 + ai * 128 + m * 16; const float rs = rsv[ai * 4 + m];
#pragma unroll
                for (int bj = 0; bj < 2; ++bj) {
                    f32x4 v0 = acc[ai][bj][m][0] * rs, v1 = acc[ai][bj][m][1] * rs;
                    if (act) {
#pragma unroll
                        for (int j = 0; j < 4; ++j) { v0[j] = silu(v0[j]); v1[j] = silu(v1[j]); }
                    }
                    u32x4 w; w.x = pk2(v0[0], v0[1]); w.y = pk2(v0[2], v0[3]); w.z = pk2(v1[0], v1[1]); w.w = pk2(v1[2], v1[3]);
                    u32x4 t; t.x = __builtin_amdgcn_ds_bpermute(baddr, w.x); t.y = __builtin_amdgcn_ds_bpermute(baddr, w.y); t.z = __builtin_amdgcn_ds_bpermute(baddr, w.z); t.w = __builtin_amdgcn_ds_bpermute(baddr, w.w);
                    store16_wt(O + (size_t)(rowp0 + ai * 128 + m * 16) * DI + colp0 + bj * 128, t);
                }
            }
    }
};
struct EpiOut {
    static constexpr bool PERM = true, AFTER_DRAIN = true, INIT = true;
    const float* xin32; bf16_t* XB; float* part;
    float* fout; const float* fgain; unsigned* cnt;
    __device__ __forceinline__ void init(f32x4 (&acc)[2][2][4][2], const pg8::Unit& u, int wr, int wc, int fr, int fq) const {
        const int row0 = u.pm * 256 + wr * 64 + fr, col0 = u.pn * 256 + wc * 32 + 8 * fq;
#pragma unroll
        for (int ai = 0; ai < 2; ++ai)
#pragma unroll
            for (int m = 0; m < 4; ++m)
#pragma unroll
                for (int bj = 0; bj < 2; ++bj) {
                    const size_t off = (size_t)(row0 + ai * 128 + m * 16) * DM + col0 + bj * 128;
                    if (xin32) { acc[ai][bj][m][0] = *(const f32x4*)(xin32 + off); acc[ai][bj][m][1] = *(const f32x4*)(xin32 + off + 4); }
                    else { const u32x4 r = *(const u32x4*)(XB + off); acc[ai][bj][m][0] = (f32x4){bflo(r.x), bfhi(r.x), bflo(r.y), bfhi(r.y)}; acc[ai][bj][m][1] = (f32x4){bflo(r.z), bfhi(r.z), bflo(r.w), bfhi(r.w)}; }
                }
    }
    __device__ __forceinline__ void fused(f32x4 (&acc)[2][2][4][2], const pg8::Unit& u, int wr, int wc, int fr, int fq, PG8_LAS unsigned char* lds, int wid, int lane) const {
        PG8_LAS float* P = (PG8_LAS float*)lds;
        const int row0 = u.pm * 256 + wr * 64 + fr, col0 = u.pn * 256 + wc * 32 + 8 * fq;
        const int L_ = fr + 16 * fq, baddr = 4 * ((L_ >> 2) + 16 * (L_ & 3)), rowp0 = u.pm * 256 + wr * 64 + (L_ >> 2), colp0 = u.pn * 256 + wc * 32 + 8 * (L_ & 3);
#pragma unroll
        for (int ai = 0; ai < 2; ++ai)
#pragma unroll
            for (int m = 0; m < 4; ++m) {
                const int row = row0 + ai * 128 + m * 16; float ss = 0.f;
#pragma unroll
                for (int bj = 0; bj < 2; ++bj) {
                    const size_t off = (size_t)row * DM + col0 + bj * 128;
                    const f32x4 v0 = acc[ai][bj][m][0], v1 = acc[ai][bj][m][1];
                    u32x4 w; w.x = pk2(v0[0], v0[1]); w.y = pk2(v0[2], v0[3]); w.z = pk2(v1[0], v1[1]); w.w = pk2(v1[2], v1[3]);
                    if (!fout) *(u32x4*)(XB + (size_t)(rowp0 + ai * 128 + m * 16) * DM + colp0 + bj * 128) = lane_regroup(w, baddr);
                    ss += (v0[0] * v0[0] + v0[1] * v0[1]) + (v0[2] * v0[2] + v0[3] * v0[3]) + (v1[0] * v1[0] + v1[1] * v1[1]) + (v1[2] * v1[2] + v1[3] * v1[3]);
                }
                ss += __shfl_xor(ss, 16); ss += __shfl_xor(ss, 32);
                if (fq == 0) P[(ai * 128 + wr * 64 + m * 16 + fr) * 4 + wc] = ss;
            }
        __syncthreads();
        const int t256 = wid * 64 + lane;
        if (!fout) {
            if (t256 < 256) { const f32x4 p = *(const PG8_LAS f32x4*)(P + t256 * 4); part[(size_t)(u.pm * 256 + t256) * 4 + u.pn] = (p[0] + p[1]) + (p[2] + p[3]); }
            __syncthreads();
            return;
        }
        PG8_LAS float* RSv = (PG8_LAS float*)(lds + 4096);
        if (t256 < 256) { const f32x4 p = *(const PG8_LAS f32x4*)(P + t256 * 4); __hip_atomic_store(part + (size_t)(u.pm * 256 + t256) * 4 + u.pn, (p[0] + p[1]) + (p[2] + p[3]), __ATOMIC_RELAXED, __HIP_MEMORY_SCOPE_AGENT); }
        asm volatile("s_waitcnt vmcnt(0)" ::: "memory");
        __syncthreads();
        if (wid == 0) {
            if (lane == 0) __hip_atomic_fetch_add(cnt + 16 * u.pm, 1u, __ATOMIC_RELAXED, __HIP_MEMORY_SCOPE_AGENT);
            unsigned sp = 0;
            while ((unsigned)__builtin_amdgcn_readfirstlane(__hip_atomic_load(cnt + 16 * u.pm, __ATOMIC_RELAXED, __HIP_MEMORY_SCOPE_AGENT)) < 4u) { __builtin_amdgcn_s_sleep(2); if (++sp > (1u << 20)) break; }
            __builtin_amdgcn_fence(__ATOMIC_ACQUIRE, "agent");
            asm volatile("s_waitcnt vmcnt(0)" ::: "memory");
        }
        __syncthreads();
        if (t256 < 256) {
            const float* pp = part + (size_t)(u.pm * 256 + t256) * 4; float s4 = 0.f;
#pragma unroll
            for (int t = 0; t < 4; ++t) s4 += __hip_atomic_load(pp + t, __ATOMIC_RELAXED, __HIP_MEMORY_SCOPE_AGENT);
            RSv[t256] = rsqrtf(s4 * (1.0f / DM) + EPS);
        }
        __syncthreads();
        f32x4 gn[2][2];
#pragma unroll
        for (int bj = 0; bj < 2; ++bj) { gn[bj][0] = *(const f32x4*)(fgain + col0 + bj * 128); gn[bj][1] = *(const f32x4*)(fgain + col0 + bj * 128 + 4); }
#pragma unroll
        for (int ai = 0; ai < 2; ++ai)
#pragma unroll
            for (int m = 0; m < 4; ++m) {
                const int rl = ai * 128 + wr * 64 + m * 16 + fr; const float rs = RSv[rl];
#pragma unroll
                for (int bj = 0; bj < 2; ++bj) {
                    const size_t off = (size_t)(u.pm * 256 + rl) * DM + col0 + bj * 128;
                    *(f32x4*)(fout + off) = acc[ai][bj][m][0] * rs * gn[bj][0]; *(f32x4*)(fout + off + 4) = acc[ai][bj][m][1] * rs * gn[bj][1];
                }
            }
    }
};

struct Ptrs {
    const float *x, *a_norm, *a_w_in, *a_ln_g, *a_ln_b, *a_w_s, *a_b_s, *a_w_out, *kv_norm, *w_kv, *b_norm, *b_w_in, *b_w_out, *final_norm;
    float* out; unsigned char* ws;
};
__device__ __forceinline__ void p0_item(const float* W, int N, int K, int k0, int n0, const float* gain, bf16_t* dst, LAS float* scr, int lane) {
    f32x4 wv[8];
#pragma unroll
    for (int i = 0; i < 8; ++i) wv[i] = __builtin_nontemporal_load((const f32x4*)(W + (size_t)(k0 + 8 * i + (lane >> 3)) * N + n0 + 4 * (lane & 7)));
#pragma unroll
    for (int i = 0; i < 8; ++i)
#pragma unroll
        for (int j = 0; j < 4; ++j) scr[(8 * i + (lane >> 3)) * 33 + 4 * (lane & 7) + j] = wv[i][j];
    asm volatile("s_waitcnt lgkmcnt(0)" ::: "memory");
    const int c = lane & 7;
    float gv[8];
    { const f32x4 g0 = gain ? *(const f32x4*)(gain + k0 + 8 * c) : (f32x4){1.f, 1.f, 1.f, 1.f}, g1 = gain ? *(const f32x4*)(gain + k0 + 8 * c + 4) : (f32x4){1.f, 1.f, 1.f, 1.f};
#pragma unroll
      for (int e = 0; e < 4; ++e) { gv[e] = g0[e]; gv[4 + e] = g1[e]; } }
#pragma unroll
    for (int j = 0; j < 4; ++j) { const int n = (lane >> 3) + 8 * j; const LAS float* s = scr + (8 * c) * 33 + n;
        u32x4 o; o.x = pk2(s[0 * 33] * gv[0], s[1 * 33] * gv[1]); o.y = pk2(s[2 * 33] * gv[2], s[3 * 33] * gv[3]); o.z = pk2(s[4 * 33] * gv[4], s[5 * 33] * gv[5]); o.w = pk2(s[6 * 33] * gv[6], s[7 * 33] * gv[7]);
        *(u32x4*)(dst + (size_t)n * K + k0 + 8 * c) = o; }
    asm volatile("s_waitcnt lgkmcnt(0)" ::: "memory");
}
__device__ __forceinline__ void phase0(const Ptrs& P, LAS unsigned char* lds, int G) {
    const int tid = opaque_tid(), lane = tid & 63, wave = tid >> 6;
    LAS float* scr = (LAS float*)(lds + wave * 8704);
    bf16_t* WA = (bf16_t*)(P.ws + WS_R2); bf16_t* WB = (bf16_t*)(P.ws + WS_WB);
    const int gw = blockIdx.x * 8 + wave, NGW = G * 8;
    for (int it = gw; it < 16384; it += NGW) {
        int r = it; const float* W; int N, K; const float* gain; int seg;
        if (r < 6144) { seg = r / 3072; r -= seg * 3072; W = P.a_w_in + (size_t)seg * DM * 6144; N = 6144; K = DM; gain = P.a_norm + seg * DM;
            const int nblk = N / 32, kb = r / nblk, n0 = (r % nblk) * 32; bf16_t* dst;
            if (n0 < 2048) dst = WA + seg * WA_LAYER + WA_UZ + (size_t)(256 * (n0 >> 7) + (n0 & 127)) * K;
            else if (n0 < 4096) dst = WA + seg * WA_LAYER + WA_V + (size_t)(n0 - 2048) * K;
            else { const int f = n0 - 4096; dst = WA + seg * WA_LAYER + WA_UZ + (size_t)(256 * (f >> 7) + 128 + (f & 127)) * K; }
            p0_item(W, N, K, kb * 64, n0, gain, dst, scr, lane); continue; }
        r -= 6144;
        if (r < 2048) { seg = r / 1024; r -= seg * 1024; W = P.a_w_out + (size_t)seg * DI * DM; N = DM; K = DI;
            const int nblk = N / 32, kb = r / nblk, n0 = (r % nblk) * 32;
            p0_item(W, N, K, kb * 64, n0, nullptr, WA + seg * WA_LAYER + WA_OUT + (size_t)n0 * K, scr, lane); continue; }
        r -= 2048;
        if (r < 2048) { W = P.w_kv; N = 4096; K = DM;
            const int nblk = N / 32, kb = r / nblk, n0 = (r % nblk) * 32;
            bf16_t* dst = (n0 < 2048) ? WB + WB_K + (size_t)n0 * K : WB + WB_VV + (size_t)(n0 - 2048) * K;
            p0_item(W, N, K, kb * 64, n0, P.kv_norm, dst, scr, lane); continue; }
        r -= 2048;
        if (r < 4096) { seg = r / 2048; r -= seg * 2048; W = P.b_w_in + (size_t)seg * DM * 4096; N = 4096; K = DM;
            const int nblk = N / 32, kb = r / nblk, n0 = (r % nblk) * 32;
            bf16_t* dst = (n0 < 2048) ? WB + (seg ? WB_Q1 : WB_Q0) + (size_t)n0 * K : WB + (seg ? WB_Z1 : WB_Z0) + (size_t)(n0 - 2048) * K;
            p0_item(W, N, K, kb * 64, n0, P.b_norm + seg * DM, dst, scr, lane); continue; }
        r -= 4096;
        { seg = r / 1024; r -= seg * 1024; W = P.b_w_out + (size_t)seg * DI * DM; N = DM; K = DI;
            const int nblk = N / 32, kb = r / nblk, n0 = (r % nblk) * 32;
            p0_item(W, N, K, kb * 64, n0, nullptr, WB + (seg ? WB_OUT1 : WB_OUT0) + (size_t)n0 * K, scr, lane); }
    }
    bf16_t* XB = (bf16_t*)(P.ws + WS_XB);
    for (int row = gw; row < MT; row += NGW) {
        const f32x4* xr = (const f32x4*)(P.x + (size_t)row * DM) + lane; f32x4 v[4]; float ss = 0.f;
#pragma unroll
        for (int j = 0; j < 4; ++j) { v[j] = __builtin_nontemporal_load(xr + 64 * j); ss += (v[j][0] * v[j][0] + v[j][1] * v[j][1]) + (v[j][2] * v[j][2] + v[j][3] * v[j][3]); }
        ss = wave_sum(ss);
        u32x2* o = (u32x2*)(XB + (size_t)row * DM) + lane;
#pragma unroll
        for (int j = 0; j < 4; ++j) o[64 * j] = (u32x2){pk2(v[j][0], v[j][1]), pk2(v[j][2], v[j][3])};
        if (lane == 0) *(f32x4*)(g_part + (size_t)row * 4) = (f32x4){ss, 0.f, 0.f, 0.f};
    }
    for (int i = blockIdx.x * 512 + tid; i < 2 * 8 * 128 * 128 / 2; i += G * 512) {
        const int e = 2 * i, s = e & 127, t = (e >> 7) & 127;
        const f32x2 w = *(const f32x2*)(P.a_w_s + e); const bool keep = (s >> 6) <= (t >> 6);
        *(unsigned*)(g_wsm + e) = keep ? pk2(w[0], w[1]) : 0u;
    }
}

__device__ __forceinline__ void phaseA2(const Ptrs& P, int layer, LAS unsigned char* lds, int G, bf16_t* YD) {
    const int tid = opaque_tid(), lane = tid & 63, wave = tid >> 6;
    LAS unsigned char* VN = lds;
    LAS unsigned char* WM = lds + 65536;
    LAS float* MU = (LAS float*)(lds + 98304);
    LAS float* RS = MU + 128;
    bf16_t* GUZ = (bf16_t*)(P.ws + WS_R0); const bf16_t* GVT = (const bf16_t*)(P.ws + WS_R1);
    const float* lg = P.a_ln_g + layer * DI; const float* lb = P.a_ln_b + layer * DI; const float* bs = P.a_b_s + layer * 8 * 128;
    u32x4 raw[8];
    {   const int nb0 = blockIdx.x >> 1, g0 = (blockIdx.x & 1) * 4;
        {
#pragma unroll
            for (int j = 0; j < 8; ++j) { const int q = tid + 512 * j, c = q >> 4, cc = q & 15; raw[j] = *(const u32x4*)(GVT + (size_t)(g0 * 256 + c) * MT + nb0 * 128 + 8 * cc); }
        }
    }
    const int r = lane & 15, kg = lane >> 4;
#pragma unroll 1
    for (int i4 = 0; i4 < 4; ++i4) {
        int nb = blockIdx.x >> 1, g = (blockIdx.x & 1) * 4 + i4;
        asm volatile("" : "+s"(nb), "+s"(g));
        u32x4 wreg[4];
#pragma unroll
        for (int j = 0; j < 4; ++j) { const int q = tid + 512 * j, t = q >> 4, cc = q & 15; wreg[j] = *(const u32x4*)(g_wsm + (size_t)(layer * 8 + g) * 16384 + t * 128 + 8 * cc); }
        if (i4 == 0) {
        if (tid < 128) {
            const f32x4* lp = (const f32x4*)(g_lnpart + (size_t)(nb * 128 + tid) * 32); float s = 0.f, q = 0.f;
#pragma unroll
            for (int j = 0; j < 8; ++j) { const f32x4 v = lp[j]; s += v[0] + v[2]; q += v[1] + v[3]; }
            const float mu = s * (1.0f / DI), var = q * (1.0f / DI) - mu * mu;
            MU[tid] = mu; RS[tid] = rsqrtf(fmaxf(var, 0.f) + EPS);
        }
        __syncthreads();
        }
        const int foff = 8 * (kg >> 1) + 16 * (kg & 1);
        u32x4 gq[8];
#pragma unroll
        for (int nt = 0; nt < 8; ++nt) gq[nt] = *(const u32x4*)(GUZ + (size_t)(nb * 128 + nt * 16 + r) * DI + g * 256 + wave * 32 + foff);
        float bsr[8];
#pragma unroll
        for (int nt = 0; nt < 8; ++nt) bsr[nt] = bs[g * 128 + nt * 16 + r];
        asm volatile("" : "+v"(bsr[0]), "+v"(bsr[1]), "+v"(bsr[2]), "+v"(bsr[3]), "+v"(bsr[4]), "+v"(bsr[5]), "+v"(bsr[6]), "+v"(bsr[7]));
#pragma unroll
        for (int j = 0; j < 8; ++j) {
            const int q = tid + 512 * j, c = q >> 4, cc = q & 15; const int f = g * 256 + c;
            const float gg = lg[f], bb = lb[f];
            const f32x4 m0 = *(const LAS f32x4*)(MU + 8 * cc), m1 = *(const LAS f32x4*)(MU + 8 * cc + 4), r0 = *(const LAS f32x4*)(RS + 8 * cc), r1 = *(const LAS f32x4*)(RS + 8 * cc + 4);
            u32x4 w;
            w.x = pk2((bflo(raw[j].x) - m0[0]) * r0[0] * gg + bb, (bfhi(raw[j].x) - m0[1]) * r0[1] * gg + bb);
            w.y = pk2((bflo(raw[j].y) - m0[2]) * r0[2] * gg + bb, (bfhi(raw[j].y) - m0[3]) * r0[3] * gg + bb);
            w.z = pk2((bflo(raw[j].z) - m1[0]) * r1[0] * gg + bb, (bfhi(raw[j].z) - m1[1]) * r1[1] * gg + bb);
            w.w = pk2((bflo(raw[j].w) - m1[2]) * r1[2] * gg + bb, (bfhi(raw[j].w) - m1[3]) * r1[3] * gg + bb);
            *(LAS u32x4*)(VN + c * 256 + ((cc ^ (c & 15)) << 4)) = w;
        }
#pragma unroll
        for (int j = 0; j < 4; ++j) { const int q = tid + 512 * j, t = q >> 4, cc = q & 15; *(LAS u32x4*)(WM + t * 256 + ((cc ^ (t & 15)) << 4)) = wreg[j]; }
        __syncthreads();
        {
            if (i4 < 3) { const int nbn = nb, gn = g + 1;
#pragma unroll
                for (int j = 0; j < 8; ++j) { const int q = tid + 512 * j, c = q >> 4, cc = q & 15; raw[j] = *(const u32x4*)(GVT + (size_t)(gn * 256 + c) * MT + nbn * 128 + 8 * cc); } }
        }
        f32x4 acc[2][8];
#pragma unroll
        for (int a = 0; a < 2; ++a)
#pragma unroll
            for (int b = 0; b < 8; ++b) acc[a][b] = (f32x4){0.f, 0.f, 0.f, 0.f};
#pragma unroll
        for (int ks = 0; ks < 4; ++ks) {
            bf16x8 va[2];
#pragma unroll
            for (int ct = 0; ct < 2; ++ct) { const int c = wave * 32 + ct * 16 + r; va[ct] = *(const LAS bf16x8*)(VN + c * 256 + (((4 * ks + kg) ^ (c & 15)) << 4)); }
#pragma unroll
            for (int nt = 0; nt < 8; ++nt) { const int t = nt * 16 + r; const bf16x8 wb = *(const LAS bf16x8*)(WM + t * 256 + (((4 * ks + kg) ^ (t & 15)) << 4));
#pragma unroll
                for (int ct = 0; ct < 2; ++ct) acc[ct][nt] = __builtin_amdgcn_mfma_f32_16x16x32_bf16(va[ct], wb, acc[ct][nt], 0, 0, 0); }
        }
#pragma unroll
        for (int nt = 0; nt < 8; ++nt) {
            const int t = nt * 16 + r; const float bias = bsr[nt];
            u32x4 gz = gq[nt];
            { auto r0 = __builtin_amdgcn_permlane16_swap(gz.x, gz.z, false, false); gz.x = r0[0]; gz.z = r0[1]; auto r1 = __builtin_amdgcn_permlane16_swap(gz.y, gz.w, false, false); gz.y = r1[0]; gz.w = r1[1]; }
            const f32x4 a0 = acc[0][nt], a1 = acc[1][nt];
            const unsigned ax = pk2n(bflo(gz.x) * (a0[0] + bias), bfhi(gz.x) * (a0[1] + bias)), ay = pk2n(bflo(gz.y) * (a0[2] + bias), bfhi(gz.y) * (a0[3] + bias));
            const unsigned bx = pk2n(bflo(gz.z) * (a1[0] + bias), bfhi(gz.z) * (a1[1] + bias)), by = pk2n(bflo(gz.w) * (a1[2] + bias), bfhi(gz.w) * (a1[3] + bias));
            auto s0 = __builtin_amdgcn_permlane16_swap(ax, bx, false, false); auto s1 = __builtin_amdgcn_permlane16_swap(ay, by, false, false);
            *(u32x4*)(YD + (size_t)(nb * 128 + t) * DI + g * 256 + wave * 32 + foff) = (u32x4){s0[0], s1[0], s0[1], s1[1]};
        }
        __syncthreads();
    }
}

constexpr float ATT_STOP = -152.0f;
template <bool DIAG>
__device__ __forceinline__ float sb_local(const f32x16& S, int l31, int hh, float (&att)[16]) {
    float run = 1.0f;
#pragma unroll
    for (int r = 15; r >= 0; --r) {
        float om = frcp(1.0f + fexp2(S[r]));
        if (DIAG) om = (16 * hh + r >= l31) ? 1.0f : om;
        const float rn = run * om;
        att[r] = run - rn; run = rn;
    }
    return run;
}
__device__ __forceinline__ void sb_scale(const float (&att)[16], float run, int hh, float& carry, bf16x8& p0, bf16x8& p1) {
    const float tot_o = __shfl_xor(run, 32);
    const float cf = fexp2(carry) * (hh == 0 ? tot_o : 1.0f);
    carry += __builtin_amdgcn_logf(run) + __builtin_amdgcn_logf(tot_o);
    u32x4 w0, w1;
    w0.x = pk2(att[0] * cf, att[1] * cf); w0.y = pk2(att[2] * cf, att[3] * cf); w0.z = pk2(att[4] * cf, att[5] * cf); w0.w = pk2(att[6] * cf, att[7] * cf);
    w1.x = pk2(att[8] * cf, att[9] * cf); w1.y = pk2(att[10] * cf, att[11] * cf); w1.z = pk2(att[12] * cf, att[13] * cf); w1.w = pk2(att[14] * cf, att[15] * cf);
    p0 = __builtin_bit_cast(bf16x8, w0); p1 = __builtin_bit_cast(bf16x8, w1);
}
constexpr int B2_SLOT = 16384, B2_NSLOT = 9, B2_FL = B2_SLOT * B2_NSLOT;
__device__ __forceinline__ void phaseB2(const Ptrs& P, LAS unsigned char* lds, int G, int dummy) {
    const int tid = opaque_tid(), lane = tid & 63, wave = __builtin_amdgcn_readfirstlane(tid >> 6), l31 = lane & 31, hh = lane >> 5;
    LAS int* FL = (LAS int*)(lds + B2_FL);
    const unsigned kb0 = l31 * 256 + ((hh ^ (l31 & 15)) << 4), vb0 = 8192 + l31 * 64 + ((((hh << 1) ^ (l31 >> 2)) & 3) << 4);
    unsigned gk, gv;
    {   const int irow = 4 * wave + (lane >> 4), key = 16 * ((irow >> 2) & 1) + 4 * (irow >> 3) + (irow & 3);
        gk = (unsigned)(key * DI + 8 * ((lane & 15) ^ (irow & 15)));
        const int d = 16 * wave + (lane >> 2);
        gv = (unsigned)(d * MT + 8 * ((lane & 3) ^ ((d >> 2) & 3))); }
    const bf16_t* Kg = (const bf16_t*)(P.ws + WS_R0); const bf16_t* VT = (const bf16_t*)(P.ws + WS_R1); bf16_t* QO = (bf16_t*)(P.ws + WS_R2); const bf16_t* SZ = (const bf16_t*)P.out;
    int res_lo = 1 << 30, res_hi = -1;
    for (int i = 0; i < 4; ++i) {
        const int c = blockIdx.x, bh = c & 63, jq = c >> 6; const int qb = 4 * jq + 3 - i;
        const int b = bh >> 4, h = bh & 15, q0 = qb * 256, tq0 = q0 + 32 * wave;
        const size_t tokbase = (size_t)b * SEQ;
        const bf16_t* kgb = Kg + tokbase * DI + h * DH;
        const bf16_t* vgb = VT + (size_t)(h * DH) * MT + tokbase;
#define B2_DMA(blk, slot) do { __builtin_amdgcn_global_load_lds((const unsigned*)(kgb + (size_t)(32 * (blk)) * DI + gk), (LAS unsigned*)(lds + (slot) * B2_SLOT + wave * 1024), 16, 0, 0); \
            __builtin_amdgcn_global_load_lds((const unsigned*)(vgb + 32 * (blk) + gv), (LAS unsigned*)(lds + (slot) * B2_SLOT + 8192 + wave * 1024), 16, 0, 0); } while (0)
        const int b0 = q0 >> 5;
        {   int sl = b0 % B2_NSLOT; bool any = false;
#pragma unroll
            for (int bi = 0; bi < 8; ++bi) { const int B = b0 + bi; if (B < res_lo || B > res_hi) { B2_DMA(B, sl); any = true; } sl = (sl == B2_NSLOT - 1) ? 0 : sl + 1; }
            if (any) { res_lo = b0; res_hi = b0 + 7; }
        }
        bf16x8 qf[8];
        { const bf16_t* qp = QO + (tokbase + tq0 + l31) * DI + h * DH + 8 * hh;
#pragma unroll
          for (int kk = 0; kk < 8; ++kk) qf[kk] = *(const bf16x8*)(qp + 16 * kk); }
        u32x4 gz[8];
        { const bf16_t* srow0 = SZ + (tokbase + tq0 + l31) * DI + h * DH + 8 * hh;
#pragma unroll
          for (int p = 0; p < 8; ++p) gz[p] = *(const u32x4*)(srow0 + 16 * p); }
        f32x16 O[4];
#pragma unroll
        for (int d = 0; d < 4; ++d)
#pragma unroll
            for (int r = 0; r < 16; ++r) O[d][r] = 0.f;
        float carry = 0.f; bool wdone = false;
        if (lane == 0) { FL[wave] = 0; FL[8 + wave] = 0; }
        int blk = b0 + wave, slot = blk % B2_NSLOT;
        int nblk = b0 - 1, nslot = (b0 + B2_NSLOT - 1) % B2_NSLOT, par = 0;
        asm volatile("s_waitcnt vmcnt(0)" ::: "memory");
        for (;;) {
            __syncthreads();
            if (dummy == 2) break;
            int nd = 0;
#pragma unroll
            for (int w = 0; w < 8; ++w) nd += FL[par * 8 + w];
            if (nd == 8) break;
            if (nblk >= 0 && nblk < res_lo) { B2_DMA(nblk, nslot); res_lo = nblk; res_hi = res_hi < nblk + 8 ? res_hi : nblk + 8; }
            if (!wdone) {
                LAS unsigned char* SB = lds + slot * B2_SLOT;
                bf16x8 kf[8], vf[8];
#pragma unroll
                for (int kk = 0; kk < 8; ++kk) kf[kk] = *(const LAS bf16x8*)(SB + (kb0 ^ (kk << 5)));
#pragma unroll
                for (int db = 0; db < 4; ++db) { vf[2 * db] = *(const LAS bf16x8*)(SB + db * 2048 + (vb0 ^ 0)); vf[2 * db + 1] = *(const LAS bf16x8*)(SB + db * 2048 + (vb0 ^ 16)); }
                asm volatile("" : "+v"(kf[0]), "+v"(kf[1]), "+v"(kf[2]), "+v"(kf[3]), "+v"(kf[4]), "+v"(kf[5]), "+v"(kf[6]), "+v"(kf[7]));
                f32x16 S;
#pragma unroll
                for (int r = 0; r < 16; ++r) S[r] = 0.f;
#pragma unroll
                for (int kk = 0; kk < 8; ++kk) S = __builtin_amdgcn_mfma_f32_32x32x16_bf16(kf[kk], qf[kk], S, 0, 0, 0);
                float att[16]; float run; bf16x8 p0, p1;
                if (32 * blk == tq0) run = sb_local<true>(S, l31, hh, att); else run = sb_local<false>(S, l31, hh, att);
                sb_scale(att, run, hh, carry, p0, p1);
#pragma unroll
                for (int db = 0; db < 4; ++db) {
                    O[db] = __builtin_amdgcn_mfma_f32_32x32x16_bf16(vf[2 * db], p0, O[db], 0, 0, 0);
                    O[db] = __builtin_amdgcn_mfma_f32_32x32x16_bf16(vf[2 * db + 1], p1, O[db], 0, 0, 0);
                }
                wdone = (__ballot(carry < ATT_STOP) == ~0ull) || (blk == 0);
            }
            if (lane == 0) FL[(par ^ 1) * 8 + wave] = wdone ? 1 : 0;
            --blk; slot = (slot == 0) ? B2_NSLOT - 1 : slot - 1; --nblk; nslot = (nslot == 0) ? B2_NSLOT - 1 : nslot - 1; par ^= 1;
            asm volatile("s_waitcnt vmcnt(0)" ::: "memory");
        }
#undef B2_DMA
        if (!dummy || carry > 1e30f)
        { bf16_t* rowp = QO + (tokbase + tq0 + l31) * DI + h * DH + 8 * hh; const bf16_t* srow = SZ + (tokbase + tq0 + l31) * DI + h * DH + 8 * hh;
#pragma unroll
          for (int p = 0; p < 8; ++p) {
              auto r0 = __builtin_amdgcn_permlane32_swap(gz[p].x, gz[p].z, false, false); gz[p].x = r0[0]; gz[p].z = r0[1];
              auto r1 = __builtin_amdgcn_permlane32_swap(gz[p].y, gz[p].w, false, false); gz[p].y = r1[0]; gz[p].w = r1[1]; }
#pragma unroll
          for (int p = 0; p < 8; ++p) {
              const int db = p >> 1, a = 2 * (p & 1); const u32x4 g = gz[p];
              unsigned ax = pk2n(O[db][4 * a] * bflo(g.x), O[db][4 * a + 1] * bfhi(g.x)), ay = pk2n(O[db][4 * a + 2] * bflo(g.y), O[db][4 * a + 3] * bfhi(g.y));
              unsigned bx = pk2n(O[db][4 * a + 4] * bflo(g.z), O[db][4 * a + 5] * bfhi(g.z)), by = pk2n(O[db][4 * a + 6] * bflo(g.w), O[db][4 * a + 7] * bfhi(g.w));
              auto s0 = __builtin_amdgcn_permlane32_swap(ax, bx, false, false); auto s1 = __builtin_amdgcn_permlane32_swap(ay, by, false, false);
              *(u32x4*)(rowp + 16 * p) = (u32x4){s0[0], s1[0], s0[1], s1[1]};
          } }
        __syncthreads();
    }
}

__device__ __forceinline__ void phaseF(const Ptrs& P, int G) {
    const int tid = opaque_tid(), lane = tid & 63, wave = tid >> 6, gw = blockIdx.x * 8 + wave, NGW = G * 8;
    const bf16_t* XB = (const bf16_t*)(P.ws + WS_XB);
    for (int row = gw; row < MT; row += NGW) {
        const float rs = rstd_of(g_part, row);
        const u32x2* xr = (const u32x2*)(XB + (size_t)row * DM) + lane; f32x4* orow = (f32x4*)(P.out + (size_t)row * DM) + lane; const f32x4* gp = (const f32x4*)P.final_norm + lane;
#pragma unroll
        for (int j = 0; j < 4; ++j) { const u32x2 r = xr[64 * j]; const f32x4 gg = gp[64 * j]; orow[64 * j] = (f32x4){bflo(r.x), bfhi(r.x), bflo(r.y), bfhi(r.y)} * rs * gg; }
    }
}

#define XB_TMO      128
#define XB_XCNT(j)  (256  + 64 * (j))
#define XB_XSUB(j)  (1280 + 64 * (j))
#define XB_XGEN(j)  (2304 + 64 * (j))
#define XB_TOP      3328
#define XB_TOPGEN   3392
#define XCD_BAR_WORDS 3456
#define XB_SPIN_CAP (1u << 18)
__device__ unsigned g_bar[XCD_BAR_WORDS];
__device__ __forceinline__ unsigned xb_ld(unsigned* p)              { return __hip_atomic_load(p, __ATOMIC_RELAXED, __HIP_MEMORY_SCOPE_AGENT); }
__device__ __forceinline__ unsigned xb_add(unsigned* p, unsigned v) { return __hip_atomic_fetch_add(p, v, __ATOMIC_RELAXED, __HIP_MEMORY_SCOPE_AGENT); }
__device__ __forceinline__ unsigned xb_xcc_id() { return (unsigned)__builtin_amdgcn_s_getreg((3 << 11) | 20) & 0xFu; }
#define XB_SPIN(cond, bar) do { unsigned _sp = 0; while (cond) { __builtin_amdgcn_s_sleep(1); \
    if ((++_sp & 255u) == 0u) { if (xb_ld(&(bar)[XB_TMO])) break; if (_sp > XB_SPIN_CAP) { atomicAdd(&(bar)[XB_TMO], 1u); break; } } } } while (0)
struct XcdBarrier { unsigned* bar; unsigned x; volatile LAS unsigned* st; };
__device__ __forceinline__ XcdBarrier xcd_barrier_post(unsigned* bar, volatile LAS unsigned* st) {
    XcdBarrier b; b.bar = bar; b.x = xb_xcc_id(); b.st = st;
    if (threadIdx.x == 0) (void)xb_add(&bar[XB_XCNT(b.x)], 1u);
    return b;
}
__device__ __forceinline__ void xcd_barrier_complete(unsigned* bar, unsigned x, unsigned& nloc, unsigned& nx) {
    const unsigned G = gridDim.x * gridDim.y * gridDim.z;
    unsigned sum, cnt, mine, sp = 0u;
    for (;;) {
        sum = 0u; cnt = 0u; mine = 0u;
#pragma unroll
        for (unsigned j = 0; j < 16; ++j) { const unsigned c = xb_ld(&bar[XB_XCNT(j)]); sum += c; cnt += (c > 0u) ? 1u : 0u; mine = (j == x) ? c : mine; }
        if (sum == G) break;
        __builtin_amdgcn_s_sleep(1);
        if ((++sp & 255u) == 0u) { if (xb_ld(&bar[XB_TMO])) break; if (sp > XB_SPIN_CAP) { atomicAdd(&bar[XB_TMO], 1u); break; } }
    }
    nloc = mine > 0u ? mine : 1u; nx = cnt > 0u ? cnt : 1u;
}
__device__ __forceinline__ void xcd_barrier_a() {
    asm volatile("s_waitcnt vmcnt(0)" ::: "memory");
    __syncthreads();
}
template <bool DRAIN> __device__ __forceinline__ void xcd_barrier_b(const XcdBarrier& b);
__device__ __forceinline__ void xcd_barrier(const XcdBarrier& b) { xcd_barrier_a(); xcd_barrier_b<true>(b); }
template <bool DRAIN> __device__ __forceinline__ void xcd_barrier_b(const XcdBarrier& b) {
    if (threadIdx.x == 0) {
        unsigned* bar = b.bar;
        if (DRAIN) __builtin_amdgcn_s_waitcnt(0);
        unsigned nloc = b.st[0], nx = b.st[1];
        if (nloc == 0u) { xcd_barrier_complete(bar, b.x, nloc, nx); b.st[0] = nloc; b.st[1] = nx; }
        const unsigned old = xb_add(&bar[XB_XSUB(b.x)], 1u);
        const unsigned gen = old / nloc;
        if (old + 1u == (gen + 1u) * nloc) {
            __builtin_amdgcn_fence(__ATOMIC_RELEASE, "agent");
            asm volatile("s_waitcnt vmcnt(0)" ::: "memory");
            const unsigned og = xb_add(&bar[XB_TOP], 1u);
            const unsigned tg = og / nx;
            if (og + 1u == (tg + 1u) * nx) xb_add(&bar[XB_TOPGEN], 1u);
            else XB_SPIN(xb_ld(&bar[XB_TOPGEN]) == tg, bar);
            __builtin_amdgcn_fence(__ATOMIC_ACQUIRE, "agent");
            xb_add(&bar[XB_XGEN(b.x)], 1u);
            asm volatile("s_waitcnt vmcnt(0)" ::: "memory");
        } else {
            XB_SPIN(xb_ld(&bar[XB_XGEN(b.x)]) == gen, bar);
            __builtin_amdgcn_fence(__ATOMIC_ACQUIRE, "agent");
            asm volatile("s_waitcnt vmcnt(0)" ::: "memory");
        }
    }
    __syncthreads();
}

constexpr int LDS_BYTES = 152 * 1024;
__global__ void __launch_bounds__(512) yoco_fwd(Ptrs P) {
    extern __shared__ __attribute__((aligned(16))) unsigned char lds_raw[];
    LAS unsigned char* lds = (LAS unsigned char*)lds_raw;
    cg::grid_group grid = cg::this_grid();
    const int G = gridDim.x, c = blockIdx.x;
    unsigned char* ws = P.ws;
    bf16_t* R0 = (bf16_t*)(ws + WS_R0); bf16_t* R1 = (bf16_t*)(ws + WS_R1); bf16_t* R2 = (bf16_t*)(ws + WS_R2); bf16_t* XB = (bf16_t*)(ws + WS_XB);
    const bf16_t* WA = (const bf16_t*)(ws + WS_R2); const bf16_t* WB = (const bf16_t*)(ws + WS_WB);

    volatile LAS unsigned* xst = (volatile LAS unsigned*)(lds + LDS_BYTES - 16);
    if (threadIdx.x < 4) xst[threadIdx.x] = 0u;
    if (blockIdx.x == 0) { for (int i = threadIdx.x; i < XCD_BAR_WORDS; i += 512) g_bar[i] = 0u; for (int i = threadIdx.x; i < 64 * 16; i += 512) g_cnt[i] = 0u; }
    __syncthreads();
    const XcdBarrier xb1 = xcd_barrier_post((unsigned*)P.out, xst);
    if (P.ws == nullptr) grid.sync();
    phase0(P, lds, G);
    if (REP_P0) { __syncthreads(); phase0(P, lds, G); }
    GSYNC(xb1);
    const XcdBarrier xb2 = xcd_barrier_post(g_bar, xst + 2);

    for (int layer = 0; layer < 2; ++layer) {
        const bf16_t* W = WA + layer * WA_LAYER;
        for (int rep = 0; rep < 1 + REP_A1; ++rep) {
        {
            pg8::Gemm g{XB, W + WA_UZ, MT, 4096, DM}; pg8::StaticOrder S; S.init(MT, 4096, G, c);
            EpiUZ E{R0, g_part};
            pg8::gemm_phase<EpiUZ, pg8::StaticOrder, true, true>(lds, g, S, E);
        }
        {
            pg8::Gemm g{W + WA_V, XB, DI, MT, DM}; pg8::StaticOrder S; S.init(DI, MT, G, c);
            EpiT<1> E{R1, g_part, g_lnpart};
            pg8::gemm_phase<EpiT<1>, pg8::StaticOrder, true, true>(lds, g, S, E);
        }
        }
        GSYNC(xb1);
        phaseA2(P, layer, lds, G, R0);
        {
            pg8::Gemm g{R0, W + WA_OUT, MT, DM, DI}; pg8::StaticOrder S; S.init(MT, DM, G, c);
            EpiOut E{nullptr, XB, g_part, nullptr, nullptr, nullptr};
            f32x4 pre[2][2][4][2];
            xcd_barrier_a();
            { pg8::Unit u0; const int t_ = opaque_tid(), w_ = t_ >> 6, l_ = t_ & 63; S.next(0, u0); E.init(pre, u0, w_ >> 2, w_ & 3, l_ & 15, l_ >> 4); }
            xcd_barrier_b<false>(xb1);
            pg8::gemm_phase_pre<EpiOut, pg8::StaticOrder, false, true>(lds, g, S, E, pre);
        }
        if (layer == 0) GSYNC(xb1); else GSYNC(xb2);
    }
    for (int layer = 0; layer < 2; ++layer) {
        for (int rep = 0; rep < 1 + (layer == 0 ? REP_B1 : 0); ++rep) {
        {
            const int N = layer == 0 ? 6144 : 4096;
            pg8::Gemm g{XB, WB + (layer == 0 ? WB_K : WB_Q1), MT, N, DM}; pg8::StaticOrder S; S.init(MT, N, G, c);
            const long long dq = (long long)((char*)R2 - (char*)R0), dz0 = (long long)((char*)P.out - (char*)R0), dz1 = (long long)((char*)P.out - (char*)R2);
            EpiRS E{layer == 0 ? R0 : R2, layer == 0 ? dq : dz1, layer == 0 ? dz0 : 0ll, QSCALE, layer == 0 ? 1 : 0, layer == 0 ? 2 : 1, g_part};
            pg8::gemm_phase<EpiRS, pg8::StaticOrder, true, true>(lds, g, S, E);
        }
        if (layer == 0) {
            pg8::Gemm g{WB + WB_VV, XB, DI, MT, DM}; pg8::StaticOrder S; S.init(DI, MT, G, c);
            EpiT<0> E{R1, g_part, nullptr};
            pg8::gemm_phase<EpiT<0>, pg8::StaticOrder, true, true>(lds, g, S, E);
        }
        }
        GSYNC(xb2);
        if (REP_B2) phaseB2(P, lds, G, REP_B2);
        phaseB2(P, lds, G, 0);
        {
            pg8::Gemm g{R2, WB + (layer ? WB_OUT1 : WB_OUT0), MT, DM, DI}; pg8::StaticOrder S; S.init(MT, DM, G, c);
            EpiOut E{nullptr, XB, g_part, layer == 1 ? P.out : nullptr, P.final_norm, g_cnt};
            f32x4 pre[2][2][4][2];
            xcd_barrier_a();
            { pg8::Unit u0; const int t_ = opaque_tid(), w_ = t_ >> 6, l_ = t_ & 63; S.next(0, u0); E.init(pre, u0, w_ >> 2, w_ & 3, l_ & 15, l_ >> 4); }
            xcd_barrier_b<false>(xb2);
            pg8::gemm_phase_pre<EpiOut, pg8::StaticOrder, false, true>(lds, g, S, E, pre);
        }
        if (layer == 0) GSYNC(xb2);
    }
}

extern "C" void kernel_launch(void* const* d_in, const int* in_sizes, int n_in, void* d_out, int out_size, void* d_ws, size_t ws_size, hipStream_t stream) {
    static int grid = 0;
    if (grid == 0) {
        if (n_in != 14 || out_size != MT * DM || ws_size < 256 * MiB) { fprintf(stderr, "kernel_launch: unexpected shapes (n_in %d out %d ws %zu)\n", n_in, out_size, ws_size); grid = -1; return; }
        int dev = 0, cus = 0, per_cu = 0;
        hipGetDevice(&dev); hipDeviceGetAttribute(&cus, hipDeviceAttributeMultiprocessorCount, dev);
        if (hipFuncSetAttribute((const void*)yoco_fwd, hipFuncAttributeMaxDynamicSharedMemorySize, LDS_BYTES) != hipSuccess) { fprintf(stderr, "kernel_launch: hipFuncSetAttribute failed\n"); grid = -1; return; }
        hipOccupancyMaxActiveBlocksPerMultiprocessor(&per_cu, (const void*)yoco_fwd, 512, LDS_BYTES);
        (void)hipGetLastError();
        grid = cus * (per_cu > 0 ? per_cu : 1);
        if (grid > 256) grid = 256;
        fprintf(stderr, "kernel_launch: cus %d per_cu %d grid %d ws %zu\n", cus, per_cu, grid, ws_size);
        if (grid != 256) { fprintf(stderr, "kernel_launch: needs 256 co-resident workgroups\n"); grid = -1; return; }
    }
    if (grid < 0) return;
    if (hipMemsetAsync(d_out, 0, XCD_BAR_WORDS * sizeof(unsigned), stream) != hipSuccess) { fprintf(stderr, "kernel_launch: memset failed\n"); return; }
    Ptrs p{};
    p.x = (const float*)d_in[0]; p.a_norm = (const float*)d_in[1]; p.a_w_in = (const float*)d_in[2]; p.a_ln_g = (const float*)d_in[3]; p.a_ln_b = (const float*)d_in[4];
    p.a_w_s = (const float*)d_in[5]; p.a_b_s = (const float*)d_in[6]; p.a_w_out = (const float*)d_in[7]; p.kv_norm = (const float*)d_in[8]; p.w_kv = (const float*)d_in[9];
    p.b_norm = (const float*)d_in[10]; p.b_w_in = (const float*)d_in[11]; p.b_w_out = (const float*)d_in[12]; p.final_norm = (const float*)d_in[13];
    p.out = (float*)d_out; p.ws = (unsigned char*)d_ws;
    void* args[] = {&p};
    hipError_t e = hipLaunchCooperativeKernel((const void*)yoco_fwd, dim3(grid), dim3(512), args, LDS_BYTES, stream);
    if (e != hipSuccess) fprintf(stderr, "kernel_launch: cooperative launch failed: %s\n", hipGetErrorString(e));
}
```
